# Optimizing an MI355X kernel written in HIP

```python
import jax, jax.numpy as jnp
from jax import lax
import numpy as np

D_MODEL = 2048
BATCH = 4
SEQ = 2048
DEPTH = 1
DEC_BATCH = 128
DEC_SEQ = 1
PAST_LEN = 16384
PAGE_SIZE = 128

N_META = 16
D_SSM = D_MODEL // 2
SSM_GROUP = 16
N_SSM_GROUPS = D_SSM // SSM_GROUP
SSM_STATE = 64
D_CONV = D_MODEL - D_SSM
N_CONV_HEADS = 8
CONV_W = 3
D_IN_PROJ = D_SSM + 3 * D_CONV
D_FF = -(-8 * D_MODEL // (3 * 256)) * 256
DEEPNORM_ALPHA = (2 * DEPTH) ** 0.25
DEEPNORM_BETA = (8 * DEPTH) ** -0.25
LN_EPS = 1e-5
RMS_EPS = 1e-6

kernel_name = "hymba_s5_shortconv_deepnorm_step"


def layer_norm(x, g, b):
    xf = x.astype(jnp.float32)
    mu = jnp.mean(xf, -1, keepdims=True)
    var = jnp.mean(jnp.square(xf - mu), -1, keepdims=True)
    y = (xf - mu) * lax.rsqrt(var + LN_EPS) * g.astype(jnp.float32) + b.astype(jnp.float32)
    return y.astype(x.dtype)


def rms_norm(x, g):
    xf = x.astype(jnp.float32)
    y = xf * lax.rsqrt(jnp.mean(jnp.square(xf), -1, keepdims=True) + RMS_EPS) * g.astype(jnp.float32)
    return y.astype(x.dtype)


def s5_discretise(a_re, a_im, log_dt, b_re, b_im):
    f32 = jnp.float32
    a_re = a_re.astype(f32); a_im = a_im.astype(f32)
    b_re = b_re.astype(f32); b_im = b_im.astype(f32)
    dt = jnp.exp(log_dt.astype(f32))[:, None]
    mag = jnp.exp(dt * a_re)
    ang = dt * a_im
    ab_re = mag * jnp.cos(ang)
    ab_im = mag * jnp.sin(ang)
    n_re = ab_re - 1.0
    n_im = ab_im
    den = a_re * a_re + a_im * a_im
    f_re = (n_re * a_re + n_im * a_im) / den
    f_im = (n_im * a_re - n_re * a_im) / den
    bb_re = f_re[..., None] * b_re - f_im[..., None] * b_im
    bb_im = f_re[..., None] * b_im + f_im[..., None] * b_re
    return ab_re, ab_im, bb_re, bb_im


def _complex_affine_combine(e1, e2):
    a1r, a1i, b1r, b1i = e1
    a2r, a2i, b2r, b2i = e2
    ar = a1r * a2r - a1i * a2i
    ai = a1r * a2i + a1i * a2r
    br = a2r * b1r - a2i * b1i + b2r
    bi = a2r * b1i + a2i * b1r + b2i
    return ar, ai, br, bi


def s5_mixer(u, s0_re, s0_im, a_re, a_im, log_dt, b_re, b_im, c_re, c_im, d_skip, w_glu):
    f32 = jnp.float32
    n, l, _ = u.shape
    uf = u.astype(f32)
    ug = uf.reshape(n, l, N_SSM_GROUPS, SSM_GROUP)
    ab_re, ab_im, bb_re, bb_im = s5_discretise(a_re, a_im, log_dt, b_re, b_im)
    x_re = jnp.einsum('nlgc,gpc->nlgp', ug, bb_re)
    x_im = jnp.einsum('nlgc,gpc->nlgp', ug, bb_im)
    s0_re = s0_re.astype(f32); s0_im = s0_im.astype(f32)
    x_re = x_re.at[:, 0].add(ab_re * s0_re - ab_im * s0_im)
    x_im = x_im.at[:, 0].add(ab_re * s0_im + ab_im * s0_re)
    a_re_t = jnp.broadcast_to(ab_re, (1, l, N_SSM_GROUPS, SSM_STATE))
    a_im_t = jnp.broadcast_to(ab_im, (1, l, N_SSM_GROUPS, SSM_STATE))
    _, _, s_re, s_im = lax.associative_scan(_complex_affine_combine, (a_re_t, a_im_t, x_re, x_im), axis=1)
    y = (jnp.einsum('nlgp,gcp->nlgc', s_re, c_re.astype(f32))
         - jnp.einsum('nlgp,gcp->nlgc', s_im, c_im.astype(f32)))
    y = y.reshape(n, l, D_SSM) + d_skip.astype(f32) * uf
    y = jax.nn.gelu(y).astype(u.dtype)
    y = y * jax.nn.sigmoid(y @ w_glu)
    return y, s_re[:, -1], s_im[:, -1]


def short_conv_mixer(b_gate, c_gate, h, buf, conv_w):
    v = c_gate * h
    vp = jnp.concatenate([buf.astype(v.dtype), v], axis=1)
    l = v.shape[1]
    conv = conv_w[0] * vp[:, 0:l]
    for k in range(1, CONV_W):
        conv = conv + conv_w[k] * vp[:, k:k + l]
    return b_gate * conv, vp[:, -(CONV_W - 1):]


def hybrid_layer(x, s_re, s_im, conv_buf, w_in, a_re, a_im, log_dt, b_re, b_im, c_re, c_im,
                 d_skip, w_glu, conv_w, g_ssm_out, g_conv_out, w_out, ln1_g, ln1_b,
                 w_gate, w_up, w_down, ln2_g, ln2_b):
    proj = x @ w_in
    u, b_gate, c_gate, h = jnp.split(proj, [D_SSM, D_SSM + D_CONV, D_SSM + 2 * D_CONV], axis=-1)
    y_ssm, s_re_new, s_im_new = s5_mixer(u, s_re, s_im, a_re, a_im, log_dt, b_re, b_im,
                                         c_re, c_im, d_skip, w_glu)
    y_conv, buf_new = short_conv_mixer(b_gate, c_gate, h, conv_buf, conv_w)
    merged = jnp.concatenate([rms_norm(y_ssm, g_ssm_out), rms_norm(y_conv, g_conv_out)], axis=-1)
    x = layer_norm(DEEPNORM_ALPHA * x + merged @ w_out, ln1_g, ln1_b)
    ffn = (jax.nn.silu(x @ w_gate) * (x @ w_up)) @ w_down
    x = layer_norm(DEEPNORM_ALPHA * x + ffn, ln2_g, ln2_b)
    return x, s_re_new, s_im_new, buf_new


def setup_inputs(seed: int = 0) -> dict:
    key = jax.random.key(seed)
    ks = jax.random.split(key, 32)
    f32 = jnp.float32
    nrm = lambda k, shape, s: jax.random.normal(k, shape, f32) * s
    G, P, C = N_SSM_GROUPS, SSM_STATE, SSM_GROUP
    n_idx = jnp.arange(P, dtype=f32)
    inp = {}
    inp['x_prompt'] = nrm(ks[0], (BATCH, SEQ, D_MODEL), 1.0)
    inp['x_sample'] = nrm(ks[1], (DEC_BATCH, DEC_SEQ, D_MODEL), 1.0)
    inp['state_ssm_re'] = nrm(ks[2], (DEPTH, DEC_BATCH, G, P), 0.5)
    inp['state_ssm_im'] = nrm(ks[3], (DEPTH, DEC_BATCH, G, P), 0.5)
    inp['state_conv'] = nrm(ks[4], (DEPTH, DEC_BATCH, CONV_W - 1, D_CONV), 1.0)
    inp['meta_tokens'] = nrm(ks[5], (N_META, D_MODEL), 1.0)
    inp['ln0_g'] = 1.0 + nrm(ks[6], (D_MODEL,), 0.02)
    inp['ln0_b'] = nrm(ks[7], (D_MODEL,), 0.02)
    inp['w_in'] = nrm(ks[8], (DEPTH, D_MODEL, D_IN_PROJ), D_MODEL ** -0.5)
    inp['ssm_a_re'] = -0.5 + nrm(ks[9], (DEPTH, G, P), 0.01)
    inp['ssm_a_im'] = jnp.pi * n_idx + nrm(ks[10], (DEPTH, G, P), 0.01)
    inp['ssm_log_dt'] = jax.random.uniform(ks[11], (DEPTH, G), f32, np.log(1e-3), np.log(1e-1))
    inp['ssm_b_re'] = nrm(ks[12], (DEPTH, G, P, C), (2 * C) ** -0.5)
    inp['ssm_b_im'] = nrm(ks[13], (DEPTH, G, P, C), (2 * C) ** -0.5)
    inp['ssm_c_re'] = nrm(ks[14], (DEPTH, G, C, P), (2 * P) ** -0.5)
    inp['ssm_c_im'] = nrm(ks[15], (DEPTH, G, C, P), (2 * P) ** -0.5)
    inp['ssm_d'] = nrm(ks[16], (DEPTH, D_SSM), 1.0)
    inp['ssm_w_glu'] = nrm(ks[17], (DEPTH, D_SSM, D_SSM), D_SSM ** -0.5)
    inp['conv_w'] = nrm(ks[18], (DEPTH, CONV_W, D_CONV), CONV_W ** -0.5)
    inp['g_ssm_out'] = 1.0 + nrm(ks[19], (DEPTH, D_SSM), 0.02)
    inp['g_conv_out'] = 1.0 + nrm(ks[20], (DEPTH, D_CONV), 0.02)
    inp['w_out'] = nrm(ks[21], (DEPTH, D_MODEL, D_MODEL), D_MODEL ** -0.5 * DEEPNORM_BETA)
    inp['ln1_g'] = 1.0 + nrm(ks[22], (DEPTH, D_MODEL), 0.02)
    inp['ln1_b'] = nrm(ks[23], (DEPTH, D_MODEL), 0.02)
    inp['w_gate'] = nrm(ks[24], (DEPTH, D_MODEL, D_FF), D_MODEL ** -0.5)
    inp['w_up'] = nrm(ks[25], (DEPTH, D_MODEL, D_FF), D_MODEL ** -0.5)
    inp['w_down'] = nrm(ks[26], (DEPTH, D_FF, D_MODEL), D_FF ** -0.5 * DEEPNORM_BETA)
    inp['ln2_g'] = 1.0 + nrm(ks[27], (DEPTH, D_MODEL), 0.02)
    inp['ln2_b'] = nrm(ks[28], (DEPTH, D_MODEL), 0.02)
    return inp


def reference(x_prompt, x_sample, state_ssm_re, state_ssm_im, state_conv, meta_tokens, ln0_g, ln0_b,
              w_in, ssm_a_re, ssm_a_im, ssm_log_dt, ssm_b_re, ssm_b_im, ssm_c_re, ssm_c_im, ssm_d,
              ssm_w_glu, conv_w, g_ssm_out, g_conv_out, w_out, ln1_g, ln1_b, w_gate, w_up, w_down,
              ln2_g, ln2_b):
    n_p = x_prompt.shape[0]
    n_s = x_sample.shape[0]
    meta = jnp.broadcast_to(meta_tokens.astype(x_prompt.dtype)[None], (n_p, N_META, D_MODEL))
    hp = layer_norm(jnp.concatenate([meta, x_prompt], axis=1), ln0_g, ln0_b)
    hs = layer_norm(x_sample, ln0_g, ln0_b)
    zeros_ssm = jnp.zeros((n_p, N_SSM_GROUPS, SSM_STATE), jnp.float32)
    zeros_conv = jnp.zeros((n_p, CONV_W - 1, D_CONV), x_prompt.dtype)
    p_re, p_im, p_cv, s_re_l, s_im_l, s_cv_l = [], [], [], [], [], []
    for l in range(DEPTH):
        w = (w_in[l], ssm_a_re[l], ssm_a_im[l], ssm_log_dt[l], ssm_b_re[l], ssm_b_im[l],
             ssm_c_re[l], ssm_c_im[l], ssm_d[l], ssm_w_glu[l], conv_w[l], g_ssm_out[l],
             g_conv_out[l], w_out[l], ln1_g[l], ln1_b[l], w_gate[l], w_up[l], w_down[l],
             ln2_g[l], ln2_b[l])
        hp, r, i, c = hybrid_layer(hp, zeros_ssm, zeros_ssm, zeros_conv, *w)
        p_re.append(r); p_im.append(i); p_cv.append(c)
        hs, r, i, c = hybrid_layer(hs, state_ssm_re[l], state_ssm_im[l], state_conv[l], *w)
        s_re_l.append(r); s_im_l.append(i); s_cv_l.append(c)
    y_prompt = hp[:, N_META:]
    y_sample = hs
    sd = state_ssm_re.dtype
    new_ssm_re_prompt = jnp.stack(p_re).astype(sd)
    new_ssm_im_prompt = jnp.stack(p_im).astype(sd)
    new_conv_prompt = jnp.stack(p_cv).astype(state_conv.dtype)
    new_ssm_re_sample = jnp.stack(s_re_l).astype(sd)
    new_ssm_im_sample = jnp.stack(s_im_l).astype(sd)
    new_conv_sample = jnp.stack(s_cv_l).astype(state_conv.dtype)
    return (y_prompt, y_sample, new_ssm_re_prompt, new_ssm_im_prompt, new_conv_prompt,
            new_ssm_re_sample, new_ssm_im_sample, new_conv_sample)
```

```cpp
#include <hip/hip_runtime.h>
#include <hip/hip_cooperative_groups.h>
#include <cstdio>
#include <cstdint>
namespace cg = cooperative_groups;
namespace pg8 {
#define PG8_LAS __attribute__((address_space(3)))
typedef unsigned short bf16_t;
typedef short bf16x8 __attribute__((ext_vector_type(8)));
typedef float f32x4 __attribute__((ext_vector_type(4)));
typedef unsigned u32x4 __attribute__((ext_vector_type(4)));
constexpr int BM = 256, BK = 64, HALF = 128, HTB = HALF * BK * 2  , STAGE_BYTES = 8 * HTB, NXCD = 8, WGM = 8;

__host__ __device__ __forceinline__ int lds_byte(int r, int c) { const int st = (r >> 4) * 2 + (c >> 5), rr = r & 15, cc = c & 31, ob = rr * 64 + cc * 2; return st * 1024 + (ob ^ (((ob >> 9) & 1) << 5)); }
__host__ __device__ __forceinline__ void stage_rc(int b, int& R, int& C) { const int st = b / 1024, sb = b % 1024, swz = sb ^ (((sb >> 9) & 1) << 5); R = (st >> 1) * 16 + swz / 64; C = (st & 1) * 32 + (swz % 64) / 2; }
__host__ __device__ __forceinline__ int perm32(int rho) { const int n = rho >> 4, i = rho & 15; return 8 * (i >> 2) + 4 * n + (i & 3); }

struct Unit { int pm, pn; };
struct Gemm { const bf16_t* A; const bf16_t* Bt; int M, N, K; };

struct StaticOrder {
    int nM, nN, nwg, G, c;
    __host__ __device__ void init(int M, int N, int G_, int c_) { nM = M / BM; nN = N / BM; nwg = nM * nN; G = G_; c = c_; }
    __host__ __device__ bool next(int i, Unit& u) const {
        const long L = (long)i * G + c; if (L >= nwg) return false;
        int wgid = (int)L; { const int q = nwg / NXCD, r = nwg % NXCD, xcd = wgid % NXCD, off = wgid / NXCD; wgid = (xcd < r ? xcd * (q + 1) : r * (q + 1) + (xcd - r) * q) + off; }
        const int nig = WGM * nN, gid = wgid / nig, fm = gid * WGM, gsz = (nM - fm) < WGM ? (nM - fm) : WGM;
        u.pm = fm + ((wgid % nig) % gsz); u.pn = (wgid % nig) / gsz; return true;
    }
    __device__ __forceinline__ void a_ready(const Unit&) const {}
    __device__ __forceinline__ void done(const Unit&) const {}
};
__device__ __forceinline__ unsigned cvt_pk_bf16(float lo, float hi) { unsigned r; asm volatile("v_cvt_pk_bf16_f32 %0, %1, %2" : "=v"(r) : "v"(lo), "v"(hi)); return r; }
template <class Epi, class Sched, bool STAMP = false>
__device__ __forceinline__ void gemm_phase(PG8_LAS unsigned char* lds, const Gemm g, const Sched& S, const Epi& E, unsigned long long* stamps) {
    const int tid = threadIdx.x, wid = __builtin_amdgcn_readfirstlane(tid >> 6), lane = tid & 63, wr = wid >> 2, wc = wid & 3, fr = lane & 15, fq = lane >> 4;
    const int K = g.K, nt = K / BK;
    int ts_lo = 0, ts_hi = 0, nts = 0; const unsigned long long rt_entry = STAMP ? (unsigned long long)wall_clock64() : 0ull;
#define PG8_STAMP() do { if (STAMP && wid == 0 && nts < 64) { const unsigned long long _c = (unsigned long long)clock64(); \
        ts_lo = (lane == nts) ? (int)(unsigned)_c : ts_lo; ts_hi = (lane == nts) ? (int)(unsigned)(_c >> 32) : ts_hi; ++nts; } } while (0)
    PG8_STAMP();
    unsigned voffA[2], voffB[2];
#pragma unroll
    for (int i = 0; i < 2; ++i) { int R, C; stage_rc(tid * 16 + i * 8192, R, C); const int Rb = Epi::PERM ? ((R & ~31) + perm32(R & 31)) : R;
        voffA[i] = (unsigned)(R * K + C) * 2u; voffB[i] = (unsigned)(Rb * K + C) * 2u; }
    const size_t kstep = (size_t)(BK * 2);
    const size_t hstep = (size_t)HALF * K * 2;
    const size_t tstep = 2 * hstep;
    const unsigned ldsw = (unsigned)wid * 1024u;
    const int aoff = lds_byte(wr * 64 + fr, fq * 8), boff = lds_byte(wc * 32 + fr, fq * 8);
#define PG8_SA(b, h) (((b) * 2 + (h)) * HTB)
#define PG8_SB(b, h) ((4 + (b) * 2 + (h)) * HTB)
#define PG8_STAGE(bufoff, gbase, voff) do { _Pragma("unroll") for (int _i = 0; _i < 2; ++_i) \
        __builtin_amdgcn_global_load_lds((const unsigned*)((const char*)(gbase) + (voff)[_i]), (PG8_LAS unsigned*)(lds + (bufoff) + ldsw + _i * 8192), 16, 0, 0); } while (0)
#define PG8_LDA(dst, b, h) do { _Pragma("unroll") for (int m = 0; m < 4; ++m) _Pragma("unroll") for (int k = 0; k < 2; ++k) dst[m][k] = *(const PG8_LAS bf16x8*)(lds + PG8_SA(b, h) + aoff + m * 2048 + k * 1024); } while (0)
#define PG8_LDB(dst, b, h) do { _Pragma("unroll") for (int n = 0; n < 2; ++n) _Pragma("unroll") for (int k = 0; k < 2; ++k) dst[n][k] = *(const PG8_LAS bf16x8*)(lds + PG8_SB(b, h) + boff + n * 2048 + k * 1024); } while (0)
#define PG8_MMA(ai, bj, At, Bt) do { __builtin_amdgcn_s_setprio(1); _Pragma("unroll") for (int m = 0; m < 4; ++m) _Pragma("unroll") for (int n = 0; n < 2; ++n) _Pragma("unroll") for (int k = 0; k < 2; ++k) \
        acc[ai][bj][m][n] = __builtin_amdgcn_mfma_f32_16x16x32_bf16(Bt[n][k], At[m][k], acc[ai][bj][m][n], 0, 0, 0); __builtin_amdgcn_s_setprio(0); } while (0)
#define PG8_WAIT_V(n) asm volatile("s_waitcnt vmcnt(" #n ")" ::: "memory")
#define PG8_WAIT_L(n) asm volatile("s_waitcnt lgkmcnt(" #n ")" ::: "memory")
#define PG8_BAR __builtin_amdgcn_s_barrier()
#define PG8_SCHED __builtin_amdgcn_sched_barrier(0)
    Unit cur, nxt; int ui = 0;
    if (!S.next(0, cur)) return;
    f32x4 acc[2][2][4][2];
#pragma unroll
    for (int a = 0; a < 2; ++a)
#pragma unroll
        for (int b = 0; b < 2; ++b)
#pragma unroll
            for (int m = 0; m < 4; ++m)
#pragma unroll
                for (int n = 0; n < 2; ++n) acc[a][b][m][n] = (f32x4){0.f, 0.f, 0.f, 0.f};
    bf16x8 At[4][2], B0[2][2], B1[2][2];
    const char* cA = (const char*)g.A + (size_t)cur.pm * tstep; const char* cB = (const char*)g.Bt + (size_t)cur.pn * tstep;
    S.a_ready(cur);
    PG8_STAGE(PG8_SB(0, 0), cB, voffB); PG8_STAGE(PG8_SA(0, 0), cA, voffA); PG8_STAGE(PG8_SB(0, 1), cB + hstep, voffB); PG8_STAGE(PG8_SA(0, 1), cA + hstep, voffA);
    if (wr == 1) PG8_BAR;
    PG8_WAIT_V(4); PG8_BAR;
    PG8_STAGE(PG8_SB(1, 0), cB + kstep, voffB); PG8_STAGE(PG8_SA(1, 0), cA + kstep, voffA); PG8_STAGE(PG8_SB(1, 1), cB + hstep + kstep, voffB);
    PG8_WAIT_V(6); PG8_BAR;
    PG8_STAMP();
    for (;;) {
        const bool has_next = S.next(ui + 1, nxt);
        const char* nA = has_next ? (const char*)g.A + (size_t)nxt.pm * tstep : cA; const char* nB = has_next ? (const char*)g.Bt + (size_t)nxt.pn * tstep : cB;
        for (int t = 0; t < nt; t += 2) {
            const bool last = (t == nt - 2);
            const char* a1 = cA + (size_t)(t + 1) * kstep;
            const char* a2 = last ? nA : cA + (size_t)(t + 2) * kstep; const char* b2 = last ? nB : cB + (size_t)(t + 2) * kstep;
            const char* a3 = a2 + kstep; const char* b3 = b2 + kstep;
            if (last && has_next) S.a_ready(nxt);
            PG8_LDB(B0, 0, 0); PG8_SCHED; PG8_LDA(At, 0, 0); PG8_STAGE(PG8_SA(1, 1), a1 + hstep, voffA);
            PG8_WAIT_L(8); PG8_BAR; PG8_WAIT_L(0); PG8_MMA(0, 0, At, B0); PG8_BAR; PG8_SCHED;
            PG8_LDB(B1, 0, 1); PG8_STAGE(PG8_SB(0, 0), b2, voffB);
            PG8_BAR; PG8_WAIT_L(0); PG8_MMA(0, 1, At, B1); PG8_BAR;
            PG8_LDA(At, 0, 1); PG8_STAGE(PG8_SA(0, 0), a2, voffA);
            PG8_BAR; PG8_WAIT_L(0); PG8_MMA(1, 0, At, B0); PG8_BAR; PG8_SCHED;
            PG8_STAGE(PG8_SB(0, 1), b2 + hstep, voffB);
            PG8_WAIT_V(6); PG8_BAR; PG8_MMA(1, 1, At, B1); PG8_BAR;
            PG8_LDB(B0, 1, 0); PG8_SCHED; PG8_LDA(At, 1, 0); PG8_STAGE(PG8_SA(0, 1), a2 + hstep, voffA);
            PG8_WAIT_L(8); PG8_BAR; PG8_WAIT_L(0); PG8_MMA(0, 0, At, B0); PG8_BAR; PG8_SCHED;
            PG8_LDB(B1, 1, 1); PG8_STAGE(PG8_SB(1, 0), b3, voffB);
            PG8_BAR; PG8_WAIT_L(0); PG8_MMA(0, 1, At, B1); PG8_BAR;
            PG8_LDA(At, 1, 1); PG8_STAGE(PG8_SA(1, 0), a3, voffA);
            PG8_BAR; PG8_WAIT_L(0); PG8_MMA(1, 0, At, B0); PG8_BAR; PG8_SCHED;
            PG8_STAGE(PG8_SB(1, 1), b3 + hstep, voffB);
            PG8_WAIT_V(6); PG8_BAR; PG8_MMA(1, 1, At, B1); PG8_BAR;
        }
        PG8_STAMP();
        if constexpr (!Epi::AFTER_DRAIN) { E(acc, cur, wr, wc, fr, fq); S.done(cur); }
        PG8_STAMP();
        if (!has_next) break;
#pragma unroll
        for (int a = 0; a < 2; ++a)
#pragma unroll
            for (int b = 0; b < 2; ++b)
#pragma unroll
                for (int m = 0; m < 4; ++m)
#pragma unroll
                    for (int n = 0; n < 2; ++n) acc[a][b][m][n] = (f32x4){0.f, 0.f, 0.f, 0.f};
        cur = nxt; cA = nA; cB = nB; ++ui;
    }
    PG8_WAIT_V(0);
    if (wr == 0) PG8_BAR;
    PG8_BAR;
    if constexpr (Epi::AFTER_DRAIN) { E.fused(acc, cur, wr, wc, fr, fq, lds, wid, lane); S.done(cur); }
    PG8_STAMP();
    if (STAMP && wid == 0) { stamps[lane] = lane < nts ? (((unsigned long long)(unsigned)ts_hi << 32) | (unsigned)ts_lo) : 0ull;
        if (lane == 62) stamps[62] = rt_entry; if (lane == 63) stamps[63] = (unsigned long long)wall_clock64(); }
#undef PG8_STAMP
#undef PG8_SA
#undef PG8_SB
#undef PG8_STAGE
#undef PG8_LDA
#undef PG8_LDB
#undef PG8_MMA
#undef PG8_WAIT_V
#undef PG8_WAIT_L
#undef PG8_BAR
#undef PG8_SCHED
}
}

#include <cstdio>
#include <ctime>
#include <cstdlib>
#include <cstring>
#include <cmath>
#include <vector>
#include <algorithm>
#define CK(x) do { hipError_t e_ = (x); if (e_ != hipSuccess) { fprintf(stderr, "HIP %s:%d %s\n", __FILE__, __LINE__, hipGetErrorString(e_)); exit(2); } } while (0)
using pg8::bf16_t; using pg8::bf16x8; using pg8::f32x4; using pg8::u32x4;
typedef unsigned u32x2 __attribute__((ext_vector_type(2)));

constexpr int D = 2048, DSSM = 1024, DPROJ = 4096, DFF = 5632;
constexpr int MROWS = 8320;
constexpr int MA = 8336;
constexpr int MPAD = 8448;
constexpr int META0 = 8320;
constexpr float ALPHA = 1.189207115002721f;
constexpr int LDS_BYTES = 155648;

constexpr size_t OFF_WGU = 0;
constexpr size_t OFF_X = OFF_WGU + (size_t)11264 * 2048 * 2;
constexpr size_t OFF_D = OFF_X + (size_t)MPAD * 2048 * 2;
constexpr size_t OFF_HMID = OFF_D;
constexpr size_t OFF_WDT = OFF_HMID + (size_t)MPAD * DFF * 2;
constexpr size_t OFF_PROJ = OFF_D;
constexpr size_t OFF_YACT = OFF_PROJ + (size_t)MPAD * DPROJ * 2;
constexpr size_t OFF_MERGED = OFF_YACT + (size_t)MPAD * 1024 * 2;
constexpr size_t OFF_WIN = OFF_MERGED + (size_t)MPAD * 2048 * 2;
constexpr size_t OFF_WGLU = OFF_WIN + (size_t)4096 * 2048 * 2;
constexpr size_t OFF_WOUT = OFF_WGLU + (size_t)1024 * 1024 * 2;
constexpr size_t OFF_SSMME = OFF_WOUT + (size_t)2048 * 2048 * 2;
constexpr size_t OFF_SSMF = OFF_SSMME + (size_t)64 * 256 * 384 * 2;
constexpr size_t OFF_SSMC = OFF_SSMF + (size_t)64 * 128 * 256 * 2;
constexpr size_t OFF_ROWSQ = OFF_SSMC + (size_t)64 * 2304 * 4;
constexpr size_t WS_END = OFF_ROWSQ + (size_t)MPAD * 4;
static_assert(OFF_WDT + (size_t)2048 * DFF * 2 <= WS_END, "wdt inside region D");
static_assert(WS_END <= (size_t)256 * 1024 * 1024, "workspace");

constexpr size_t O_YP = 0, O_YS = 16777216, O_PRE = 17039360, O_PIM = 17055744, O_PCV = 17072128, O_SRE = 17080320, O_SIM = 17604608, O_SCV = 18128896;

struct Args {
    const float *x_prompt, *x_sample, *st_re, *st_im, *st_conv, *meta, *ln0_g, *ln0_b, *w_in, *a_re, *a_im, *log_dt, *b_re, *b_im, *c_re, *c_im, *ssm_d, *w_glu, *conv_w, *g_ssm, *g_conv,
        *w_out, *ln1_g, *ln1_b, *w_gate, *w_up, *w_down, *ln2_g, *ln2_b;
    float* out; unsigned char* ws;
};

__device__ __forceinline__ float bf2f(unsigned short b) { return __uint_as_float(((unsigned)b) << 16); }
__device__ __forceinline__ float bflo(unsigned w) { return __uint_as_float(w << 16); }
__device__ __forceinline__ float bfhi(unsigned w) { return __uint_as_float(w & 0xffff0000u); }
__device__ __forceinline__ unsigned pk(float lo, float hi) { return pg8::cvt_pk_bf16(lo, hi); }
__device__ __forceinline__ float wave_sum(float v) {
#pragma unroll
    for (int o = 32; o > 0; o >>= 1) v += __shfl_xor(v, o);
    return v;
}
__device__ __forceinline__ float sigmoidf_(float z) { return 1.0f / (1.0f + __expf(-z)); }
__device__ __forceinline__ float gelu_tanh(float x) { const float z = 1.5957691216057308f * (x + 0.044715f * x * x * x); return x * sigmoidf_(z); }

__device__ __forceinline__ void transpose_tile(const float* __restrict__ src, int ld, int k0, int n0, bf16_t* __restrict__ dst, int ldd, int drow0, float* T) {
    const int tid = threadIdx.x;
    { const int row = tid >> 4, c4 = (tid & 15) * 4;
#pragma unroll
      for (int i = 0; i < 2; ++i) { const float4 v = *(const float4*)(src + (size_t)(k0 + row + 32 * i) * ld + n0 + c4); float* t = T + (row + 32 * i) * 65 + c4; t[0] = v.x; t[1] = v.y; t[2] = v.z; t[3] = v.w; } }
    __syncthreads();
    { const int n = tid >> 3, kc = (tid & 7) * 8; const float* t = T + kc * 65 + n;
      u32x4 w; w.x = pk(t[0], t[65]); w.y = pk(t[130], t[195]); w.z = pk(t[260], t[325]); w.w = pk(t[390], t[455]);
      *(u32x4*)(dst + (size_t)(drow0 + n) * ldd + k0 + kc) = w; }
    __syncthreads();
}

__device__ __forceinline__ void ln_row_stats(const f32x4 (&v)[8], float& mean, float& rstd) {
    float s = 0.f;
#pragma unroll
    for (int i = 0; i < 8; ++i) s += v[i][0] + v[i][1] + v[i][2] + v[i][3];
    mean = wave_sum(s) * (1.0f / 2048.0f);
    float q = 0.f;
#pragma unroll
    for (int i = 0; i < 8; ++i) {
#pragma unroll
        for (int j = 0; j < 4; ++j) { const float d = v[i][j] - mean; q += d * d; } }
    rstd = rsqrtf(wave_sum(q) * (1.0f / 2048.0f) + 1e-5f);
}

__device__ void ssm_precompute(const Args& a, int g, unsigned char* smem) {
    float* Apr = (float*)smem;
    float* Api = Apr + 17 * 64;
    float* Bbr = Api + 17 * 64;
    float* Bbi = Bbr + 1024;
    float* Cr = Bbi + 1024;
    float* Ci = Cr + 1024;
    float* Km = Ci + 1024;
    float* Fr = Km + 4096;
    float* Fi = Fr + 64;
    const int tid = threadIdx.x;
    if (tid < 64) {
        const int p = tid;
        const double dt = exp((double)a.log_dt[g]);
        const double are = (double)a.a_re[g * 64 + p], aim = (double)a.a_im[g * 64 + p];
        const double twopi = 6.283185307179586476925;
        for (int d = 0; d <= 16; ++d) {
            const double mag = exp((double)d * dt * are);
            double ang = (double)d * dt * aim;
            ang -= twopi * rint(ang / twopi);
            const float angf = (float)ang;
            Apr[d * 64 + p] = (float)(mag * (double)cosf(angf));
            Api[d * 64 + p] = (float)(mag * (double)sinf(angf));
        }
        {
            const double mag = exp(dt * are); double ang = dt * aim; ang -= twopi * rint(ang / twopi);
            const double abr = mag * (double)cosf((float)ang), abi = mag * (double)sinf((float)ang);
            const double c = (double)cosf((float)ang), s = (double)sinf((float)ang);
            const double nre = expm1(dt * are) * c + (c - 1.0), nim = mag * s;
            (void)abr; (void)abi;
            const double den = are * are + aim * aim;
            Fr[p] = (float)((nre * are + nim * aim) / den);
            Fi[p] = (float)((nim * are - nre * aim) / den);
        }
    }
    for (int i = tid; i < 1024; i += 512) { Cr[i] = a.c_re[g * 1024 + i]; Ci[i] = a.c_im[g * 1024 + i]; }
    __syncthreads();
    for (int i = tid; i < 1024; i += 512) { const int p = i >> 4; const float br = a.b_re[g * 1024 + i], bi = a.b_im[g * 1024 + i]; const float fr = Fr[p], fi = Fi[p];
        Bbr[i] = fr * br - fi * bi; Bbi[i] = fr * bi + fi * br; }
    __syncthreads();
    {
        const int d = tid >> 5, c = (tid >> 1) & 15, cb = (tid & 1) * 8;
        float acc[8];
#pragma unroll
        for (int j = 0; j < 8; ++j) acc[j] = 0.f;
        for (int p = 0; p < 64; ++p) {
            const float cr = Cr[c * 64 + p], ci = Ci[c * 64 + p], ar = Apr[d * 64 + p], ai = Api[d * 64 + p];
            const float xr = cr * ar - ci * ai, xi = cr * ai + ci * ar;
#pragma unroll
            for (int j = 0; j < 8; ++j) acc[j] += xr * Bbr[p * 16 + cb + j] - xi * Bbi[p * 16 + cb + j];
        }
#pragma unroll
        for (int j = 0; j < 8; ++j) Km[(d * 16 + c) * 16 + cb + j] = acc[j];
    }
    __syncthreads();
    bf16_t* ME = (bf16_t*)(a.ws + OFF_SSMME) + (size_t)g * 256 * 384;
    for (int ch = tid; ch < 256 * 48; ch += 512) {
        const int row = ch / 48, kc = (ch % 48) * 8, t = row >> 4, c = row & 15;
        float v[8];
        if (kc < 256) { const int j = kc >> 4, c0 = kc & 15;
#pragma unroll
            for (int e = 0; e < 8; ++e) v[e] = (j <= t) ? Km[((t - j) * 16 + c) * 16 + c0 + e] : 0.f;
        } else { const bool im = kc >= 320; const int p0 = kc - (im ? 320 : 256);
#pragma unroll
            for (int e = 0; e < 8; ++e) { const int p = p0 + e; const float cr = Cr[c * 64 + p], ci = Ci[c * 64 + p], ar = Apr[(t + 1) * 64 + p], ai = Api[(t + 1) * 64 + p];
                v[e] = im ? -(cr * ai + ci * ar) : (cr * ar - ci * ai); } }
        u32x4 w; w.x = pk(v[0], v[1]); w.y = pk(v[2], v[3]); w.z = pk(v[4], v[5]); w.w = pk(v[6], v[7]);
        *(u32x4*)(ME + (size_t)row * 384 + kc) = w;
    }
    bf16_t* FT = (bf16_t*)(a.ws + OFF_SSMF) + (size_t)g * 128 * 256;
    for (int ch = tid; ch < 128 * 32; ch += 512) {
        const int row = ch >> 5, kc = (ch & 31) * 8, im = row >> 6, p = row & 63, j = kc >> 4, c0 = kc & 15;
        const float ar = Apr[(15 - j) * 64 + p], ai = Api[(15 - j) * 64 + p];
        float v[8];
#pragma unroll
        for (int e = 0; e < 8; ++e) { const float br = Bbr[p * 16 + c0 + e], bi = Bbi[p * 16 + c0 + e]; v[e] = im ? (ar * bi + ai * br) : (ar * br - ai * bi); }
        u32x4 w; w.x = pk(v[0], v[1]); w.y = pk(v[2], v[3]); w.z = pk(v[4], v[5]); w.w = pk(v[6], v[7]);
        *(u32x4*)(FT + (size_t)row * 256 + kc) = w;
    }
    float* SC = (float*)(a.ws + OFF_SSMC) + (size_t)g * 2304;
    if (tid < 64) { SC[tid] = Apr[64 + tid]; SC[64 + tid] = Api[64 + tid]; SC[128 + tid] = Apr[16 * 64 + tid]; SC[192 + tid] = Api[16 * 64 + tid]; }
    for (int i = tid; i < 1024; i += 512) { SC[256 + i] = Bbr[i]; SC[1280 + i] = Bbi[i]; }
    __syncthreads();
}

__device__ void ln0_rows(const Args& a, int rg, int wid, int lane) {
    const int r = rg * 8 + wid;
    bf16_t* X = (bf16_t*)(a.ws + OFF_X) + (size_t)r * D;
    if (r >= MA) {
#pragma unroll
        for (int i = 0; i < 8; ++i) *(u32x2*)(X + i * 256 + lane * 4) = (u32x2){0u, 0u};
        return; }
    const float* src = r < 8192 ? a.x_prompt + (size_t)r * D : (r < META0 ? a.x_sample + (size_t)(r - 8192) * D : a.meta + (size_t)(r - META0) * D);
    f32x4 v[8];
#pragma unroll
    for (int i = 0; i < 8; ++i) v[i] = *(const f32x4*)(src + i * 256 + lane * 4);
    float mean, rstd; ln_row_stats(v, mean, rstd);
#pragma unroll
    for (int i = 0; i < 8; ++i) { const f32x4 gg = *(const f32x4*)(a.ln0_g + i * 256 + lane * 4), bb = *(const f32x4*)(a.ln0_b + i * 256 + lane * 4);
        const f32x4 y = (v[i] - mean) * rstd * gg + bb;
        *(u32x2*)(X + i * 256 + lane * 4) = (u32x2){pk(y[0], y[1]), pk(y[2], y[3])}; }
}

__device__ void phase_prep(const Args& a, unsigned char* smem) {
    const int tid = threadIdx.x, wid = tid >> 6, lane = tid & 63;
    { const int gi = blockIdx.x * 512 + tid; if (gi < MPAD) ((float*)(a.ws + OFF_ROWSQ))[gi] = 0.f; }
    constexpr int N_SSM = 64, N_LN = MPAD / 8, T_WIN = 32 * 64, T_WGLU = 16 * 16, T_WOUT = 32 * 32, T_G = 32 * 88;
    constexpr int N_T = T_WIN + T_WGLU + T_WOUT + 2 * T_G, N_ITEMS = N_SSM + N_LN + N_T;
    for (int it = blockIdx.x; it < N_ITEMS; it += gridDim.x) {
        if (it < N_SSM) { ssm_precompute(a, it, smem); continue; }
        int j = it - N_SSM;
        if (j < N_LN) { ln0_rows(a, j, wid, lane); continue; }
        j -= N_LN;
        float* T = (float*)smem;
        if (j < T_WIN) { transpose_tile(a.w_in, DPROJ, (j >> 6) * 64, (j & 63) * 64, (bf16_t*)(a.ws + OFF_WIN), 2048, (j & 63) * 64, T); continue; }
        j -= T_WIN;
        if (j < T_WGLU) { transpose_tile(a.w_glu, 1024, (j >> 4) * 64, (j & 15) * 64, (bf16_t*)(a.ws + OFF_WGLU), 1024, (j & 15) * 64, T); continue; }
        j -= T_WGLU;
        if (j < T_WOUT) { transpose_tile(a.w_out, 2048, (j >> 5) * 64, (j & 31) * 64, (bf16_t*)(a.ws + OFF_WOUT), 2048, (j & 31) * 64, T); continue; }
        j -= T_WOUT;
        { const bool up = j >= T_G; if (up) j -= T_G; const int kt = j / 88, nt = j % 88, n0 = nt * 64;
          transpose_tile(up ? a.w_up : a.w_gate, DFF, kt * 64, n0, (bf16_t*)(a.ws + OFF_WGU), 2048, (n0 >> 7) * 256 + (n0 & 127) + (up ? 128 : 0), T); }
    }
}

struct EpiProj { static constexpr bool PERM = true, AFTER_DRAIN = false; bf16_t* O; int ldc;
    __device__ __forceinline__ void operator()(const f32x4 (&acc)[2][2][4][2], const pg8::Unit& u, int wr, int wc, int fr, int fq) const {
        const int row0 = u.pm * 256 + wr * 64 + fr, col0 = u.pn * 256 + wc * 32 + 8 * fq;
#pragma unroll
        for (int ai = 0; ai < 2; ++ai)
#pragma unroll
            for (int m = 0; m < 4; ++m) { bf16_t* rowp = O + (size_t)(row0 + ai * 128 + m * 16) * ldc + col0;
#pragma unroll
                for (int bj = 0; bj < 2; ++bj) { const f32x4 v0 = acc[ai][bj][m][0], v1 = acc[ai][bj][m][1];
                    u32x4 w; w.x = pk(v0[0], v0[1]); w.y = pk(v0[2], v0[3]); w.z = pk(v1[0], v1[1]); w.w = pk(v1[2], v1[3]);
                    *(u32x4*)(rowp + bj * 128) = w; } }
    }
};
struct EpiGlu { static constexpr bool PERM = true, AFTER_DRAIN = false; const bf16_t* Y; bf16_t* O; float* rowsq;
    __device__ __forceinline__ void operator()(const f32x4 (&acc)[2][2][4][2], const pg8::Unit& u, int wr, int wc, int fr, int fq) const {
        const int row0 = u.pm * 256 + wr * 64 + fr, col0 = u.pn * 256 + wc * 32 + 8 * fq;
#pragma unroll
        for (int ai = 0; ai < 2; ++ai)
#pragma unroll
            for (int m = 0; m < 4; ++m) { const int row = row0 + ai * 128 + m * 16; float ss = 0.f;
#pragma unroll
                for (int bj = 0; bj < 2; ++bj) { const f32x4 z0 = acc[ai][bj][m][0], z1 = acc[ai][bj][m][1];
                    const u32x4 yv = *(const u32x4*)(Y + (size_t)row * 1024 + col0 + bj * 128);
                    float o[8];
                    o[0] = bflo(yv.x) * sigmoidf_(z0[0]); o[1] = bfhi(yv.x) * sigmoidf_(z0[1]); o[2] = bflo(yv.y) * sigmoidf_(z0[2]); o[3] = bfhi(yv.y) * sigmoidf_(z0[3]);
                    o[4] = bflo(yv.z) * sigmoidf_(z1[0]); o[5] = bfhi(yv.z) * sigmoidf_(z1[1]); o[6] = bflo(yv.w) * sigmoidf_(z1[2]); o[7] = bfhi(yv.w) * sigmoidf_(z1[3]);
#pragma unroll
                    for (int e = 0; e < 8; ++e) ss += o[e] * o[e];
                    u32x4 w; w.x = pk(o[0], o[1]); w.y = pk(o[2], o[3]); w.z = pk(o[4], o[5]); w.w = pk(o[6], o[7]);
                    *(u32x4*)(O + (size_t)row * 2048 + col0 + bj * 128) = w; }
                ss += __shfl_xor(ss, 16); ss += __shfl_xor(ss, 32);
                if (fq == 0 && row < MROWS) atomicAdd(rowsq + row, ss); }
    }
};
struct EpiRes { static constexpr bool PERM = false, AFTER_DRAIN = false; const bf16_t* X; float* O;
    __device__ __forceinline__ void operator()(const f32x4 (&acc)[2][2][4][2], const pg8::Unit& u, int wr, int wc, int fr, int fq) const {
        const int row0 = u.pm * 256 + wr * 64 + fr, col0 = u.pn * 256 + wc * 32 + 4 * fq;
#pragma unroll
        for (int ai = 0; ai < 2; ++ai)
#pragma unroll
            for (int m = 0; m < 4; ++m) { const int row = row0 + ai * 128 + m * 16; if (row >= MROWS) continue;
#pragma unroll
                for (int bj = 0; bj < 2; ++bj)
#pragma unroll
                    for (int n = 0; n < 2; ++n) { const int col = col0 + bj * 128 + n * 16; const u32x2 xv = *(const u32x2*)(X + (size_t)row * 2048 + col);
                        f32x4 r; r[0] = ALPHA * bflo(xv.x) + acc[ai][bj][m][n][0]; r[1] = ALPHA * bfhi(xv.x) + acc[ai][bj][m][n][1]; r[2] = ALPHA * bflo(xv.y) + acc[ai][bj][m][n][2]; r[3] = ALPHA * bfhi(xv.y) + acc[ai][bj][m][n][3];
                        *(f32x4*)(O + (size_t)row * 2048 + col) = r; } }
    }
};
struct EpiGateUp { static constexpr bool PERM = true, AFTER_DRAIN = false; bf16_t* O;
    __device__ __forceinline__ void operator()(const f32x4 (&acc)[2][2][4][2], const pg8::Unit& u, int wr, int wc, int fr, int fq) const {
        const int row0 = u.pm * 256 + wr * 64 + fr, col0 = u.pn * 128 + wc * 32 + 8 * fq;
#pragma unroll
        for (int ai = 0; ai < 2; ++ai)
#pragma unroll
            for (int m = 0; m < 4; ++m) { const int row = row0 + ai * 128 + m * 16; float h[8];
#pragma unroll
                for (int n = 0; n < 2; ++n)
#pragma unroll
                    for (int e = 0; e < 4; ++e) { const float gt = acc[ai][0][m][n][e], up = acc[ai][1][m][n][e]; h[n * 4 + e] = gt * sigmoidf_(gt) * up; }
                u32x4 w; w.x = pk(h[0], h[1]); w.y = pk(h[2], h[3]); w.z = pk(h[4], h[5]); w.w = pk(h[6], h[7]);
                *(u32x4*)(O + (size_t)row * DFF + col0) = w; }
    }
};

template <class Epi> __device__ __forceinline__ void run_gemm(unsigned char* smem, const bf16_t* A, const bf16_t* Bt, int M, int N, int K, const Epi& E) {
    pg8::Gemm g; g.A = A; g.Bt = Bt; g.M = M; g.N = N; g.K = K;
    pg8::StaticOrder S; S.init(M, N, (int)gridDim.x, (int)blockIdx.x);
    pg8::gemm_phase<Epi, pg8::StaticOrder, false>((PG8_LAS unsigned char*)smem, g, S, E, nullptr);
}

constexpr int USTR = 528;
__device__ void ssm_item(const Args& a, int n, int g, unsigned char* smem) {
    unsigned char* U = smem;
    unsigned char* S = smem + 144 * USTR;
    const int tid = threadIdx.x, wid = tid >> 6, lane = tid & 63, fr = lane & 15, fq = lane >> 4;
    const bf16_t* PROJ = (const bf16_t*)(a.ws + OFF_PROJ);
    for (int i = tid; i < 144 * 32; i += 512) {
        const int ch = i >> 5, j = (i >> 1) & 15, hh = i & 1;
        u32x4 v = (u32x4){0u, 0u, 0u, 0u};
        if (ch < 129) { const int row = ch == 0 ? META0 + j : n * 2048 + (ch - 1) * 16 + j; v = *(const u32x4*)(PROJ + (size_t)row * DPROJ + g * 16 + hh * 8); }
        *(u32x4*)(U + ch * USTR + j * 32 + hh * 16) = v;
    }
    __syncthreads();
    {
        const bf16_t* FT = (const bf16_t*)(a.ws + OFF_SSMF) + (size_t)g * 128 * 256 + (size_t)(wid * 16 + fr) * 256 + fq * 8;
        bf16x8 bfr[8];
#pragma unroll
        for (int kk = 0; kk < 8; ++kk) bfr[kk] = *(const bf16x8*)(FT + kk * 32);
#pragma unroll 1
        for (int mt = 0; mt < 9; ++mt) {
            f32x4 acc = (f32x4){0.f, 0.f, 0.f, 0.f};
#pragma unroll
            for (int kk = 0; kk < 8; ++kk) { const bf16x8 av = *(const bf16x8*)(U + (mt * 16 + fr) * USTR + (kk * 32 + fq * 8) * 2); acc = __builtin_amdgcn_mfma_f32_16x16x32_bf16(av, bfr[kk], acc, 0, 0, 0); }
#pragma unroll
            for (int j = 0; j < 4; ++j) *(float*)(S + (mt * 16 + fq * 4 + j) * USTR + (wid * 16 + fr) * 4) = acc[j];
        }
    }
    __syncthreads();
    if (wid == 0) {
        const float* SC = (const float*)(a.ws + OFF_SSMC) + (size_t)g * 2304;
        const float ar = SC[128 + lane], ai = SC[192 + lane];
        float sr = 0.f, si = 0.f;
#pragma unroll 4
        for (int ch = 0; ch < 129; ++ch) {
            const float lr = *(const float*)(S + ch * USTR + lane * 4), li = *(const float*)(S + ch * USTR + 256 + lane * 4);
            *(bf16_t*)(S + ch * USTR + lane * 2) = (bf16_t)(pk(sr, 0.f) & 0xffffu);
            *(bf16_t*)(S + ch * USTR + 128 + lane * 2) = (bf16_t)(pk(si, 0.f) & 0xffffu);
            const float nr = ar * sr - ai * si + lr, ni = ar * si + ai * sr + li;
            sr = nr; si = ni;
        }
        a.out[O_PRE + (size_t)(n * 64 + g) * 64 + lane] = sr;
        a.out[O_PIM + (size_t)(n * 64 + g) * 64 + lane] = si;
    }
    __syncthreads();
    {
        const bf16_t* ME = (const bf16_t*)(a.ws + OFF_SSMME) + (size_t)g * 256 * 384;
        const float dsk = a.ssm_d[g * 16 + fr];
        bf16_t* YA = (bf16_t*)(a.ws + OFF_YACT);
#pragma unroll 1
        for (int ti = 0; ti < 2; ++ti) {
            const int t = wid * 2 + ti;
            const bf16_t* MEr = ME + (size_t)(t * 16 + fr) * 384 + fq * 8;
            bf16x8 bm[12];
#pragma unroll
            for (int kk = 0; kk < 12; ++kk) bm[kk] = *(const bf16x8*)(MEr + kk * 32);
#pragma unroll 1
            for (int mt = 0; mt < 9; ++mt) {
                f32x4 acc = (f32x4){0.f, 0.f, 0.f, 0.f};
#pragma unroll
                for (int kk = 0; kk < 8; ++kk) if (kk <= wid) { const bf16x8 av = *(const bf16x8*)(U + (mt * 16 + fr) * USTR + (kk * 32 + fq * 8) * 2); acc = __builtin_amdgcn_mfma_f32_16x16x32_bf16(av, bm[kk], acc, 0, 0, 0); }
#pragma unroll
                for (int kk = 0; kk < 4; ++kk) { const bf16x8 av = *(const bf16x8*)(S + (mt * 16 + fr) * USTR + (kk * 32 + fq * 8) * 2); acc = __builtin_amdgcn_mfma_f32_16x16x32_bf16(av, bm[8 + kk], acc, 0, 0, 0); }
#pragma unroll
                for (int j = 0; j < 4; ++j) { const int ch = mt * 16 + fq * 4 + j;
                    if (ch >= 1 && ch < 129) { const float uv = bf2f(*(const bf16_t*)(U + ch * USTR + (t * 16 + fr) * 2)); const float y = gelu_tanh(acc[j] + dsk * uv);
                        YA[(size_t)(n * 2048 + (ch - 1) * 16 + t) * 1024 + g * 16 + fr] = (bf16_t)(pk(y, 0.f) & 0xffffu); } }
            }
        }
    }
    __syncthreads();
}

__device__ void sample_ssm_item(const Args& a, int b, int g, int lane) {
    const float* SC = (const float*)(a.ws + OFF_SSMC) + (size_t)g * 2304;
    const bf16_t* PROJ = (const bf16_t*)(a.ws + OFF_PROJ) + (size_t)(8192 + b) * DPROJ + g * 16;
    const u32x4 u0 = *(const u32x4*)PROJ, u1 = *(const u32x4*)(PROJ + 8);
    float uu[16];
    uu[0] = bflo(u0.x); uu[1] = bfhi(u0.x); uu[2] = bflo(u0.y); uu[3] = bfhi(u0.y); uu[4] = bflo(u0.z); uu[5] = bfhi(u0.z); uu[6] = bflo(u0.w); uu[7] = bfhi(u0.w);
    uu[8] = bflo(u1.x); uu[9] = bfhi(u1.x); uu[10] = bflo(u1.y); uu[11] = bfhi(u1.y); uu[12] = bflo(u1.z); uu[13] = bfhi(u1.z); uu[14] = bflo(u1.w); uu[15] = bfhi(u1.w);
    float xr = 0.f, xi = 0.f;
#pragma unroll
    for (int q = 0; q < 4; ++q) { const f32x4 br = *(const f32x4*)(SC + 256 + lane * 16 + q * 4), bi = *(const f32x4*)(SC + 1280 + lane * 16 + q * 4);
#pragma unroll
        for (int e = 0; e < 4; ++e) { xr += br[e] * uu[q * 4 + e]; xi += bi[e] * uu[q * 4 + e]; } }
    const size_t so = (size_t)(b * 64 + g) * 64 + lane;
    const float s0r = a.st_re[so], s0i = a.st_im[so], ar = SC[lane], ai = SC[64 + lane];
    const float sr = ar * s0r - ai * s0i + xr, si = ar * s0i + ai * s0r + xi;
    a.out[O_SRE + so] = sr; a.out[O_SIM + so] = si;
    float mine = 0.f;
#pragma unroll
    for (int c = 0; c < 16; ++c) { const float part = a.c_re[(size_t)(g * 16 + c) * 64 + lane] * sr - a.c_im[(size_t)(g * 16 + c) * 64 + lane] * si;
        const float tot = wave_sum(part); const float y = gelu_tanh(tot + a.ssm_d[g * 16 + c] * uu[c]); if (lane == c) mine = y; }
    if (lane < 16) ((bf16_t*)(a.ws + OFF_YACT))[(size_t)(8192 + b) * 1024 + g * 16 + lane] = (bf16_t)(pk(mine, 0.f) & 0xffffu);
}

__device__ __forceinline__ void unpack8(const u32x4 v, float (&o)[8]) { o[0] = bflo(v.x); o[1] = bfhi(v.x); o[2] = bflo(v.y); o[3] = bfhi(v.y); o[4] = bflo(v.z); o[5] = bfhi(v.z); o[6] = bflo(v.w); o[7] = bfhi(v.w); }
__device__ __forceinline__ void load_v8(const bf16_t* PROJ, int row, int j, float (&v)[8]) {
    float c[8], h[8]; unpack8(*(const u32x4*)(PROJ + (size_t)row * DPROJ + 2048 + j), c); unpack8(*(const u32x4*)(PROJ + (size_t)row * DPROJ + 3072 + j), h);
#pragma unroll
    for (int e = 0; e < 8; ++e) v[e] = c[e] * h[e];
}
__device__ void conv_row(const Args& a, int r, int lane) {
    const bf16_t* PROJ = (const bf16_t*)(a.ws + OFF_PROJ);
    float y[2][8]; float ss = 0.f;
#pragma unroll
    for (int hh = 0; hh < 2; ++hh) {
        const int j = hh * 512 + lane * 8;
        float vc[8], v1[8], v2[8], bg[8];
        load_v8(PROJ, r, j, vc);
        unpack8(*(const u32x4*)(PROJ + (size_t)r * DPROJ + 1024 + j), bg);
        if (r < 8192) { const int tp = r & 2047; const int r1 = tp >= 1 ? r - 1 : META0 + 15, r2 = tp >= 2 ? r - 2 : META0 + 14 + tp;
            load_v8(PROJ, r1, j, v1); load_v8(PROJ, r2, j, v2);
            if (tp >= 2046) { float* o = a.out + O_PCV + (size_t)((r >> 11) * 2 + (tp - 2046)) * 1024 + j; *(f32x4*)o = (f32x4){vc[0], vc[1], vc[2], vc[3]}; *(f32x4*)(o + 4) = (f32x4){vc[4], vc[5], vc[6], vc[7]}; }
        } else { const int b = r - 8192; const float* sc = a.st_conv + (size_t)b * 2048 + j;
            const f32x4 p0 = *(const f32x4*)sc, p1 = *(const f32x4*)(sc + 4), q0 = *(const f32x4*)(sc + 1024), q1 = *(const f32x4*)(sc + 1028);
#pragma unroll
            for (int e = 0; e < 4; ++e) { v2[e] = p0[e]; v2[4 + e] = p1[e]; v1[e] = q0[e]; v1[4 + e] = q1[e]; }
            float* o = a.out + O_SCV + (size_t)b * 2048 + j; *(f32x4*)o = q0; *(f32x4*)(o + 4) = q1; *(f32x4*)(o + 1024) = (f32x4){vc[0], vc[1], vc[2], vc[3]}; *(f32x4*)(o + 1028) = (f32x4){vc[4], vc[5], vc[6], vc[7]}; }
        const f32x4 w0a = *(const f32x4*)(a.conv_w + j), w0b = *(const f32x4*)(a.conv_w + j + 4), w1a = *(const f32x4*)(a.conv_w + 1024 + j), w1b = *(const f32x4*)(a.conv_w + 1024 + j + 4),
                    w2a = *(const f32x4*)(a.conv_w + 2048 + j), w2b = *(const f32x4*)(a.conv_w + 2048 + j + 4);
#pragma unroll
        for (int e = 0; e < 8; ++e) { const float w0 = e < 4 ? w0a[e & 3] : w0b[e & 3], w1 = e < 4 ? w1a[e & 3] : w1b[e & 3], w2 = e < 4 ? w2a[e & 3] : w2b[e & 3];
            const float cv = w0 * v2[e] + w1 * v1[e] + w2 * vc[e]; y[hh][e] = bg[e] * cv; ss += y[hh][e] * y[hh][e]; }
    }
    const float rr = rsqrtf(wave_sum(ss) * (1.0f / 1024.0f) + 1e-6f);
    bf16_t* MG = (bf16_t*)(a.ws + OFF_MERGED) + (size_t)r * 2048 + 1024;
#pragma unroll
    for (int hh = 0; hh < 2; ++hh) { const int j = hh * 512 + lane * 8; const f32x4 ga = *(const f32x4*)(a.g_conv + j), gb = *(const f32x4*)(a.g_conv + j + 4);
        u32x4 w; w.x = pk(y[hh][0] * rr * ga[0], y[hh][1] * rr * ga[1]); w.y = pk(y[hh][2] * rr * ga[2], y[hh][3] * rr * ga[3]); w.z = pk(y[hh][4] * rr * gb[0], y[hh][5] * rr * gb[1]); w.w = pk(y[hh][6] * rr * gb[2], y[hh][7] * rr * gb[3]);
        *(u32x4*)(MG + j) = w; }
}

__device__ void phase_mixers(const Args& a, unsigned char* smem) {
    const int tid = threadIdx.x, wid = tid >> 6, lane = tid & 63;
    for (int it = blockIdx.x; it < 256; it += gridDim.x) ssm_item(a, it >> 6, it & 63, smem);
    const int gw = blockIdx.x * 8 + wid, nw = gridDim.x * 8;
    for (int it = gw; it < 128 * 64; it += nw) sample_ssm_item(a, it >> 6, it & 63, lane);
    for (int r = gw; r < MROWS; r += nw) conv_row(a, r, lane);
}

__device__ void phase_norm_ssm(const Args& a) {
    const int wid = threadIdx.x >> 6, lane = threadIdx.x & 63; const int gw = blockIdx.x * 8 + wid, nw = gridDim.x * 8;
    const float* rowsq = (const float*)(a.ws + OFF_ROWSQ);
    for (int r = gw; r < MROWS; r += nw) {
        const float rr = rsqrtf(rowsq[r] * (1.0f / 1024.0f) + 1e-6f);
        bf16_t* MG = (bf16_t*)(a.ws + OFF_MERGED) + (size_t)r * 2048;
#pragma unroll
        for (int hh = 0; hh < 2; ++hh) { const int j = hh * 512 + lane * 8; float v[8]; unpack8(*(const u32x4*)(MG + j), v);
            const f32x4 ga = *(const f32x4*)(a.g_ssm + j), gb = *(const f32x4*)(a.g_ssm + j + 4);
            u32x4 w; w.x = pk(v[0] * rr * ga[0], v[1] * rr * ga[1]); w.y = pk(v[2] * rr * ga[2], v[3] * rr * ga[3]); w.z = pk(v[4] * rr * gb[0], v[5] * rr * gb[1]); w.w = pk(v[6] * rr * gb[2], v[7] * rr * gb[3]);
            *(u32x4*)(MG + j) = w; }
    }
}
__device__ void phase_ln1(const Args& a, unsigned char* smem) {
    const int wid = threadIdx.x >> 6, lane = threadIdx.x & 63; const int gw = blockIdx.x * 8 + wid, nw = gridDim.x * 8;
    for (int r = gw; r < MROWS; r += nw) {
        const float* src = a.out + (size_t)r * D; bf16_t* X = (bf16_t*)(a.ws + OFF_X) + (size_t)r * D;
        f32x4 v[8];
#pragma unroll
        for (int i = 0; i < 8; ++i) v[i] = *(const f32x4*)(src + i * 256 + lane * 4);
        float mean, rstd; ln_row_stats(v, mean, rstd);
#pragma unroll
        for (int i = 0; i < 8; ++i) { const f32x4 gg = *(const f32x4*)(a.ln1_g + i * 256 + lane * 4), bb = *(const f32x4*)(a.ln1_b + i * 256 + lane * 4);
            const f32x4 y = (v[i] - mean) * rstd * gg + bb;
            *(u32x2*)(X + i * 256 + lane * 4) = (u32x2){pk(y[0], y[1]), pk(y[2], y[3])}; }
    }
    __syncthreads();
    for (int j = blockIdx.x; j < 88 * 32; j += gridDim.x) transpose_tile(a.w_down, 2048, (j >> 5) * 64, (j & 31) * 64, (bf16_t*)(a.ws + OFF_WDT), DFF, (j & 31) * 64, (float*)smem);
}
__device__ void phase_ln2(const Args& a) {
    const int wid = threadIdx.x >> 6, lane = threadIdx.x & 63; const int gw = blockIdx.x * 8 + wid, nw = gridDim.x * 8;
    for (int r = gw; r < MROWS; r += nw) {
        float* src = a.out + (size_t)r * D;
        f32x4 v[8];
#pragma unroll
        for (int i = 0; i < 8; ++i) v[i] = *(const f32x4*)(src + i * 256 + lane * 4);
        float mean, rstd; ln_row_stats(v, mean, rstd);
#pragma unroll
        for (int i = 0; i < 8; ++i) { const f32x4 gg = *(const f32x4*)(a.ln2_g + i * 256 + lane * 4), bb = *(const f32x4*)(a.ln2_b + i * 256 + lane * 4);
            *(f32x4*)(src + i * 256 + lane * 4) = (v[i] - mean) * rstd * gg + bb; }
    }
}

__device__ __forceinline__ void run_phase(const Args& a, int ph, unsigned char* smem) {
    unsigned char* ws = a.ws;
    switch (ph) {
    case 0: phase_prep(a, smem); break;
    case 1: { EpiProj E; E.O = (bf16_t*)(ws + OFF_PROJ); E.ldc = DPROJ; run_gemm(smem, (const bf16_t*)(ws + OFF_X), (const bf16_t*)(ws + OFF_WIN), MPAD, DPROJ, 2048, E); } break;
    case 2: phase_mixers(a, smem); break;
    case 3: { EpiGlu E; E.Y = (const bf16_t*)(ws + OFF_YACT); E.O = (bf16_t*)(ws + OFF_MERGED); E.rowsq = (float*)(ws + OFF_ROWSQ); run_gemm(smem, (const bf16_t*)(ws + OFF_YACT), (const bf16_t*)(ws + OFF_WGLU), MPAD, 1024, 1024, E); } break;
    case 4: phase_norm_ssm(a); break;
    case 5: { EpiRes E; E.X = (const bf16_t*)(ws + OFF_X); E.O = a.out; run_gemm(smem, (const bf16_t*)(ws + OFF_MERGED), (const bf16_t*)(ws + OFF_WOUT), MPAD, 2048, 2048, E); } break;
    case 6: phase_ln1(a, smem); break;
    case 7: { EpiGateUp E; E.O = (bf16_t*)(ws + OFF_HMID); run_gemm(smem, (const bf16_t*)(ws + OFF_X), (const bf16_t*)(ws + OFF_WGU), MPAD, 11264, 2048, E); } break;
    case 8: { EpiRes E; E.X = (const bf16_t*)(ws + OFF_X); E.O = a.out; run_gemm(smem, (const bf16_t*)(ws + OFF_HMID), (const bf16_t*)(ws + OFF_WDT), MPAD, 2048, DFF, E); } break;
    case 9: phase_ln2(a); break;
    }
}

#ifndef MULTI_LAUNCH
#define MULTI_LAUNCH 1
#endif
#if MULTI_LAUNCH
template <int PH> __global__ void __launch_bounds__(512, 2) k_ph(Args a) {
    extern __shared__ __attribute__((aligned(16))) unsigned char smem[];
    run_phase(a, PH, smem);
}
template <int PH> static void launch_ph(const Args& a, int grid, hipStream_t stream) {
    static bool init = false;
    if (!init) { (void)hipFuncSetAttribute((const void*)k_ph<PH>, hipFuncAttributeMaxDynamicSharedMemorySize, LDS_BYTES); init = true; }
    hipLaunchKernelGGL(k_ph<PH>, dim3(grid), dim3(512), LDS_BYTES, stream, a);
}
#else
__global__ void __launch_bounds__(512, 2) hymba_fwd(Args a) {
    extern __shared__ __attribute__((aligned(16))) unsigned char smem[];
    cg::grid_group grid = cg::this_grid();
    run_phase(a, 0, smem); grid.sync();
    run_phase(a, 1, smem); grid.sync();
    run_phase(a, 2, smem); grid.sync();
    run_phase(a, 3, smem); grid.sync();
    run_phase(a, 4, smem); grid.sync();
    run_phase(a, 5, smem); grid.sync();
    run_phase(a, 6, smem); grid.sync();
    run_phase(a, 7, smem); grid.sync();
    run_phase(a, 8, smem); grid.sync();
    run_phase(a, 9, smem);
}
#endif
extern "C" void kernel_launch(void* const* d_in, const int* in_sizes, int n_in, void* d_out, int out_size, void* d_ws, size_t ws_size, hipStream_t stream) {
    static int grid_blocks = 0;
    if (!grid_blocks) {
        int dev = 0, cus = 0;
        (void)hipGetDevice(&dev);
        (void)hipDeviceGetAttribute(&cus, hipDeviceAttributeMultiprocessorCount, dev);
#if !MULTI_LAUNCH
        int per_cu = 0;
        (void)hipFuncSetAttribute((const void*)hymba_fwd, hipFuncAttributeMaxDynamicSharedMemorySize, LDS_BYTES);
        (void)hipOccupancyMaxActiveBlocksPerMultiprocessor(&per_cu, (const void*)hymba_fwd, 512, LDS_BYTES);
        if (per_cu < 1) fprintf(stderr, "occupancy query returned %d workgroups per CU\n", per_cu);
#endif
        grid_blocks = cus;
        if (ws_size < WS_END) fprintf(stderr, "workspace too small: %zu < %zu\n", ws_size, (size_t)WS_END);
    }
    Args a{};
    const float** pp = (const float**)&a;
    for (int i = 0; i < 29; ++i) pp[i] = (const float*)d_in[i];
    a.out = (float*)d_out; a.ws = (unsigned char*)d_ws;
#if MULTI_LAUNCH
    launch_ph<0>(a, grid_blocks, stream); launch_ph<1>(a, grid_blocks, stream); launch_ph<2>(a, grid_blocks, stream); launch_ph<3>(a, grid_blocks, stream); launch_ph<4>(a, grid_blocks, stream);
    launch_ph<5>(a, grid_blocks, stream); launch_ph<6>(a, grid_blocks, stream); launch_ph<7>(a, grid_blocks, stream); launch_ph<8>(a, grid_blocks, stream); launch_ph<9>(a, grid_blocks, stream);
#else
    void* args[] = {&a};
    hipError_t e = hipLaunchCooperativeKernel((const void*)hymba_fwd, dim3(grid_blocks), dim3(512), args, LDS_BYTES, stream);
    if (e != hipSuccess) fprintf(stderr, "cooperative launch failed: %s (grid %d)\n", hipGetErrorString(e), grid_blocks);
#endif
}
```

```cpp
#include <hip/hip_runtime.h>
#include <hip/hip_cooperative_groups.h>
#include <cstdio>
#include <cstdint>
namespace cg = cooperative_groups;
__device__ __forceinline__ int tid_() { int t = (int)threadIdx.x; asm volatile("" : "+v"(t)); return t; }
namespace pg8 {
#define PG8_LAS __attribute__((address_space(3)))
typedef unsigned short bf16_t;
typedef short bf16x8 __attribute__((ext_vector_type(8)));
typedef float f32x4 __attribute__((ext_vector_type(4)));
typedef unsigned u32x4 __attribute__((ext_vector_type(4)));
constexpr int BM = 256, BK = 64, HALF = 128, HTB = HALF * BK * 2  , STAGE_BYTES = 8 * HTB, NXCD = 8, WGM = 4;

__host__ __device__ __forceinline__ int lds_byte(int r, int c) { const int st = (r >> 4) * 2 + (c >> 5), rr = r & 15, cc = c & 31, ob = rr * 64 + cc * 2; return st * 1024 + (ob ^ (((ob >> 9) & 1) << 5)); }
__host__ __device__ __forceinline__ void stage_rc(int b, int& R, int& C) { const int st = b / 1024, sb = b % 1024, swz = sb ^ (((sb >> 9) & 1) << 5); R = (st >> 1) * 16 + swz / 64; C = (st & 1) * 32 + (swz % 64) / 2; }
__host__ __device__ __forceinline__ int perm32(int rho) { const int n = rho >> 4, i = rho & 15; return 8 * (i >> 2) + 4 * n + (i & 3); }

struct Unit { int pm, pn, kt0, nkt, tail; };
struct Gemm { const bf16_t* A; const bf16_t* Bt; int M, N, K; };

struct StaticOrder {
    int nM, nN, nwg, G, c, ktiles;
    __host__ __device__ void init(int M, int N, int G_, int c_) { nM = M / BM; nN = N / BM; nwg = nM * nN; G = G_; c = c_; }
    __host__ __device__ bool next(int i, Unit& u) const {
        const long L = (long)i * G + c; if (L >= nwg) return false;
        int wgid = (int)L; { const int q = nwg / NXCD, r = nwg % NXCD, xcd = wgid % NXCD, off = wgid / NXCD; wgid = (xcd < r ? xcd * (q + 1) : r * (q + 1) + (xcd - r) * q) + off; }
        const int nig = WGM * nN, gid = wgid / nig, fm = gid * WGM, gsz = (nM - fm) < WGM ? (nM - fm) : WGM;
        u.pm = fm + ((wgid % nig) % gsz); u.pn = (wgid % nig) / gsz; u.kt0 = 0; u.nkt = ktiles; u.tail = 0; return true;
    }
    __device__ __forceinline__ void a_ready(const Unit&) const {}
    __device__ __forceinline__ void done(const Unit&) const {}
};
__device__ __forceinline__ unsigned cvt_pk_bf16(float lo, float hi) { unsigned r; asm volatile("v_cvt_pk_bf16_f32 %0, %1, %2" : "=v"(r) : "v"(lo), "v"(hi)); return r; }
template <class Epi, class Sched, bool STAMP = false, bool SP2 = true, bool ALIGN_EPI = false>
__device__ __forceinline__ void gemm_phase(PG8_LAS unsigned char* lds, const Gemm g, const Sched& S, const Epi& E, unsigned long long* stamps) {
    const int tid = tid_(), wid = __builtin_amdgcn_readfirstlane(tid >> 6), lane = tid & 63, wr = wid >> 2, wc = wid & 3, fr = lane & 15, fq = lane >> 4;
    const int K = g.K;
    int ts_lo = 0, ts_hi = 0, nts = 0; const unsigned long long rt_entry = STAMP ? (unsigned long long)wall_clock64() : 0ull;
#define PG8_STAMP() do { if (STAMP && wid == 0 && nts < 64) { const unsigned long long _c = (unsigned long long)clock64(); \
        ts_lo = (lane == nts) ? (int)(unsigned)_c : ts_lo; ts_hi = (lane == nts) ? (int)(unsigned)(_c >> 32) : ts_hi; ++nts; } } while (0)
    PG8_STAMP();
    unsigned voffA[2], voffB[2];
#pragma unroll
    for (int i = 0; i < 2; ++i) { int R, C; stage_rc(tid * 16 + i * 8192, R, C); const int Rb = Epi::PERM ? ((R & ~31) + perm32(R & 31)) : R;
        voffA[i] = (unsigned)(R * K + C) * 2u; voffB[i] = (unsigned)(Rb * K + C) * 2u; }
    const size_t kstep = (size_t)(BK * 2);
    const size_t hstep = (size_t)HALF * K * 2;
    const size_t tstep = 2 * hstep;
    const unsigned ldsw = (unsigned)wid * 1024u;
    const int aoff = lds_byte(wr * 64 + fr, fq * 8), boff = lds_byte(wc * 32 + fr, fq * 8);
#define PG8_SA(b, h) (((b) * 2 + (h)) * HTB)
#define PG8_SB(b, h) ((4 + (b) * 2 + (h)) * HTB)
#define PG8_STAGE(bufoff, gbase, voff) do { _Pragma("unroll") for (int _i = 0; _i < 2; ++_i) \
        __builtin_amdgcn_global_load_lds((const unsigned*)((const char*)(gbase) + (voff)[_i]), (PG8_LAS unsigned*)(lds + (bufoff) + ldsw + _i * 8192), 16, 0, 0); } while (0)
#define PG8_LDA(dst, b, h) do { _Pragma("unroll") for (int m = 0; m < 4; ++m) _Pragma("unroll") for (int k = 0; k < 2; ++k) dst[m][k] = *(const PG8_LAS bf16x8*)(lds + PG8_SA(b, h) + aoff + m * 2048 + k * 1024); } while (0)
#define PG8_LDB(dst, b, h) do { _Pragma("unroll") for (int n = 0; n < 2; ++n) _Pragma("unroll") for (int k = 0; k < 2; ++k) dst[n][k] = *(const PG8_LAS bf16x8*)(lds + PG8_SB(b, h) + boff + n * 2048 + k * 1024); } while (0)
#define PG8_MMA(ai, bj, At, Bt) do { __builtin_amdgcn_s_setprio(1); _Pragma("unroll") for (int m = 0; m < 4; ++m) _Pragma("unroll") for (int n = 0; n < 2; ++n) _Pragma("unroll") for (int k = 0; k < 2; ++k) \
        acc[ai][bj][m][n] = __builtin_amdgcn_mfma_f32_16x16x32_bf16(Bt[n][k], At[m][k], acc[ai][bj][m][n], 0, 0, 0); __builtin_amdgcn_s_setprio(0); } while (0)
#define PG8_WAIT_V(n) asm volatile("s_waitcnt vmcnt(" #n ")" ::: "memory")
#define PG8_WAIT_L(n) asm volatile("s_waitcnt lgkmcnt(" #n ")" ::: "memory")
#define PG8_BAR __builtin_amdgcn_s_barrier()
#define PG8_SCHED __builtin_amdgcn_sched_barrier(0)
    Unit cur, nxt; int ui = 0;
    if (!S.next(0, cur)) return;
    f32x4 acc[2][2][4][2];
#pragma unroll
    for (int a = 0; a < 2; ++a)
#pragma unroll
        for (int b = 0; b < 2; ++b)
#pragma unroll
            for (int m = 0; m < 4; ++m)
#pragma unroll
                for (int n = 0; n < 2; ++n) acc[a][b][m][n] = (f32x4){0.f, 0.f, 0.f, 0.f};
    bf16x8 At[4][2], B0[2][2], B1[2][2];
    const char* cA = (const char*)g.A + (size_t)cur.pm * tstep + (size_t)cur.kt0 * kstep; const char* cB = (const char*)g.Bt + (size_t)cur.pn * tstep + (size_t)cur.kt0 * kstep;
    S.a_ready(cur);
    if constexpr (SP2) {
        PG8_STAGE(PG8_SB(0, 0), cB, voffB); PG8_STAGE(PG8_SB(0, 1), cB + hstep, voffB); PG8_STAGE(PG8_SA(0, 0), cA, voffA); PG8_STAGE(PG8_SA(0, 1), cA + hstep, voffA);
        if (wr == 1) PG8_BAR;
        PG8_WAIT_V(2); PG8_BAR;
        PG8_STAGE(PG8_SB(1, 0), cB + kstep, voffB); PG8_STAGE(PG8_SA(1, 0), cA + kstep, voffA); PG8_STAGE(PG8_SB(1, 1), cB + hstep + kstep, voffB);
        PG8_WAIT_V(6); PG8_BAR;
    } else {
    PG8_STAGE(PG8_SB(0, 0), cB, voffB); PG8_STAGE(PG8_SA(0, 0), cA, voffA); PG8_STAGE(PG8_SB(0, 1), cB + hstep, voffB); PG8_STAGE(PG8_SA(0, 1), cA + hstep, voffA);
    if (wr == 1) PG8_BAR;
    PG8_WAIT_V(4); PG8_BAR;
    PG8_STAGE(PG8_SB(1, 0), cB + kstep, voffB); PG8_STAGE(PG8_SA(1, 0), cA + kstep, voffA); PG8_STAGE(PG8_SB(1, 1), cB + hstep + kstep, voffB);
    PG8_WAIT_V(6); PG8_BAR;
    }
    PG8_STAMP();
    for (;;) {
        const bool has_next = S.next(ui + 1, nxt);
        const char* nA = has_next ? (const char*)g.A + (size_t)nxt.pm * tstep + (size_t)nxt.kt0 * kstep : cA; const char* nB = has_next ? (const char*)g.Bt + (size_t)nxt.pn * tstep + (size_t)nxt.kt0 * kstep : cB;
        const int nt = cur.nkt;
        for (int t = 0; t < nt; t += 2) {
            const bool last = (t == nt - 2);
            if constexpr (Epi::HAS_MID) { if (t == E.mid_t && !cur.tail) E.mid(acc, cur, wr, fr); }
            const char* a1 = cA + (size_t)(t + 1) * kstep;
            const char* a2 = last ? nA : cA + (size_t)(t + 2) * kstep; const char* b2 = last ? nB : cB + (size_t)(t + 2) * kstep;
            const char* a3 = a2 + kstep; const char* b3 = b2 + kstep;
            if (last && has_next) S.a_ready(nxt);
            if constexpr (SP2) {
            PG8_LDB(B0, 0, 0); PG8_LDB(B1, 0, 1); PG8_SCHED; PG8_LDA(At, 0, 0); PG8_STAGE(PG8_SA(1, 1), a1 + hstep, voffA);
            PG8_WAIT_V(8); PG8_WAIT_L(0); PG8_BAR; PG8_MMA(0, 0, At, B0); PG8_MMA(0, 1, At, B1); PG8_BAR; PG8_SCHED;
            PG8_LDA(At, 0, 1); PG8_STAGE(PG8_SB(0, 0), b2, voffB); PG8_STAGE(PG8_SB(0, 1), b2 + hstep, voffB); PG8_STAGE(PG8_SA(0, 0), a2, voffA);
            PG8_WAIT_V(8); PG8_WAIT_L(0); PG8_BAR; PG8_MMA(1, 0, At, B0); PG8_MMA(1, 1, At, B1); PG8_BAR; PG8_SCHED;
            PG8_LDB(B0, 1, 0); PG8_LDB(B1, 1, 1); PG8_SCHED; PG8_LDA(At, 1, 0); PG8_STAGE(PG8_SA(0, 1), a2 + hstep, voffA);
            PG8_WAIT_V(8); PG8_WAIT_L(0); PG8_BAR; PG8_MMA(0, 0, At, B0); PG8_MMA(0, 1, At, B1); PG8_BAR; PG8_SCHED;
            PG8_LDA(At, 1, 1); PG8_STAGE(PG8_SB(1, 0), b3, voffB); PG8_STAGE(PG8_SB(1, 1), b3 + hstep, voffB); PG8_STAGE(PG8_SA(1, 0), a3, voffA);
            PG8_WAIT_V(8); PG8_WAIT_L(0); PG8_BAR; PG8_MMA(1, 0, At, B0); PG8_MMA(1, 1, At, B1); PG8_BAR; PG8_SCHED;
            } else {
            PG8_LDB(B0, 0, 0); PG8_SCHED; PG8_LDA(At, 0, 0); PG8_STAGE(PG8_SA(1, 1), a1 + hstep, voffA);
            PG8_WAIT_L(8); PG8_BAR; PG8_WAIT_L(0); PG8_MMA(0, 0, At, B0); PG8_BAR; PG8_SCHED;
            PG8_LDB(B1, 0, 1); PG8_STAGE(PG8_SB(0, 0), b2, voffB);
            PG8_BAR; PG8_WAIT_L(0); PG8_MMA(0, 1, At, B1); PG8_BAR;
            PG8_LDA(At, 0, 1); PG8_STAGE(PG8_SA(0, 0), a2, voffA);
            PG8_BAR; PG8_WAIT_L(0); PG8_MMA(1, 0, At, B0); PG8_BAR; PG8_SCHED;
            PG8_STAGE(PG8_SB(0, 1), b2 + hstep, voffB);
            PG8_WAIT_V(6); PG8_BAR; PG8_MMA(1, 1, At, B1); PG8_BAR;
            PG8_LDB(B0, 1, 0); PG8_SCHED; PG8_LDA(At, 1, 0); PG8_STAGE(PG8_SA(0, 1), a2 + hstep, voffA);
            PG8_WAIT_L(8); PG8_BAR; PG8_WAIT_L(0); PG8_MMA(0, 0, At, B0); PG8_BAR; PG8_SCHED;
            PG8_LDB(B1, 1, 1); PG8_STAGE(PG8_SB(1, 0), b3, voffB);
            PG8_BAR; PG8_WAIT_L(0); PG8_MMA(0, 1, At, B1); PG8_BAR;
            PG8_LDA(At, 1, 1); PG8_STAGE(PG8_SA(1, 0), a3, voffA);
            PG8_BAR; PG8_WAIT_L(0); PG8_MMA(1, 0, At, B0); PG8_BAR; PG8_SCHED;
            PG8_STAGE(PG8_SB(1, 1), b3 + hstep, voffB);
            PG8_WAIT_V(6); PG8_BAR; PG8_MMA(1, 1, At, B1); PG8_BAR;
            }
        }
        PG8_STAMP();
        if constexpr (ALIGN_EPI) { if (wr == 0) PG8_BAR; }
        if constexpr (!Epi::AFTER_DRAIN) { E(acc, cur, wr, wc, fr, fq); S.done(cur); }
        PG8_STAMP();
        if (!has_next) break;
#pragma unroll
        for (int a = 0; a < 2; ++a)
#pragma unroll
            for (int b = 0; b < 2; ++b)
#pragma unroll
                for (int m = 0; m < 4; ++m)
#pragma unroll
                    for (int n = 0; n < 2; ++n) acc[a][b][m][n] = (f32x4){0.f, 0.f, 0.f, 0.f};
        cur = nxt; cA = nA; cB = nB; ++ui;
        if constexpr (ALIGN_EPI) { if (wr == 1) PG8_BAR; }
    }
    PG8_WAIT_V(0);
    if constexpr (!ALIGN_EPI) { if (wr == 0) PG8_BAR; }
    PG8_BAR;
    if constexpr (Epi::AFTER_DRAIN) { E.fused(acc, cur, wr, wc, fr, fq, lds, wid, lane); S.done(cur); }
    PG8_STAMP();
    if (STAMP && wid == 0) { stamps[lane] = lane < nts ? (((unsigned long long)(unsigned)ts_hi << 32) | (unsigned)ts_lo) : 0ull;
        if (lane == 62) stamps[62] = rt_entry; if (lane == 63) stamps[63] = (unsigned long long)wall_clock64(); }
#undef PG8_STAMP
#undef PG8_SA
#undef PG8_SB
#undef PG8_STAGE
#undef PG8_LDA
#undef PG8_LDB
#undef PG8_MMA
#undef PG8_WAIT_V
#undef PG8_WAIT_L
#undef PG8_BAR
#undef PG8_SCHED
}
}

#include <cstdio>
#include <ctime>
#include <cstdlib>
#include <cstring>
#include <cmath>
#include <vector>
#include <algorithm>
#define CK(x) do { hipError_t e_ = (x); if (e_ != hipSuccess) { fprintf(stderr, "HIP %s:%d %s\n", __FILE__, __LINE__, hipGetErrorString(e_)); exit(2); } } while (0)
using pg8::bf16_t; using pg8::bf16x8; using pg8::f32x4; using pg8::u32x4;
typedef unsigned u32x2 __attribute__((ext_vector_type(2)));

constexpr int D = 2048, DSSM = 1024, DPROJ = 4096, DFF = 5632;
constexpr int MROWS = 8320;
constexpr int MA = 8336;
constexpr int MPAD = 8448;
constexpr int META0 = 8320;
constexpr float ALPHA = 1.189207115002721f;
constexpr int S_PROJ = 8, S_OUT = 8, S_DOWN = 11;
constexpr int LDS_BYTES = 155648;

constexpr size_t OFF_WGU = 0;
constexpr size_t OFF_X = OFF_WGU + (size_t)11264 * 2048 * 2;
constexpr size_t OFF_D = OFF_X + (size_t)MPAD * 2048 * 2;
constexpr size_t OFF_HMID = OFF_D;
constexpr size_t OFF_WDT = OFF_HMID + (size_t)MPAD * DFF * 2;
constexpr size_t OFF_PROJ = OFF_D;
constexpr size_t OFF_YACT = OFF_PROJ + (size_t)MPAD * DPROJ * 2;
constexpr size_t OFF_MERGED = OFF_YACT + (size_t)MPAD * 1024 * 2;
constexpr size_t OFF_Z1 = OFF_PROJ;
constexpr size_t OFF_Z2 = OFF_WGU;
constexpr size_t OFF_WIN = OFF_MERGED + (size_t)MPAD * 2048 * 2;
constexpr size_t OFF_WGLU = OFF_WIN + (size_t)4096 * 2048 * 2;
constexpr size_t OFF_WOUT = OFF_WGLU + (size_t)1024 * 1024 * 2;
constexpr size_t OFF_SSMME = OFF_WOUT + (size_t)2048 * 2048 * 2;
constexpr size_t OFF_SSMF = OFF_SSMME + (size_t)64 * 256 * 384 * 2;
constexpr size_t OFF_SSMC = OFF_SSMF + (size_t)64 * 128 * 256 * 2;
constexpr size_t OFF_ROWSQ = OFF_SSMC + (size_t)64 * 2304 * 4;
constexpr size_t OFF_BAR = OFF_ROWSQ + (size_t)MPAD * 4;
constexpr size_t BAR_BYTES = 16384;
constexpr size_t OFF_SLAB = OFF_BAR + BAR_BYTES;
constexpr size_t WS_END = OFF_SLAB + (size_t)8 * 144 * 4096 * 4;
static_assert(OFF_WDT + (size_t)2048 * DFF * 2 <= WS_END, "wdt inside region D");
static_assert(WS_END <= (size_t)256 * 1024 * 1024, "workspace");

constexpr size_t O_YP = 0, O_YS = 16777216, O_PRE = 17039360, O_PIM = 17055744, O_PCV = 17072128, O_SRE = 17080320, O_SIM = 17604608, O_SCV = 18128896;

struct Args {
    const float *x_prompt, *x_sample, *st_re, *st_im, *st_conv, *meta, *ln0_g, *ln0_b, *w_in, *a_re, *a_im, *log_dt, *b_re, *b_im, *c_re, *c_im, *ssm_d, *w_glu, *conv_w, *g_ssm, *g_conv,
        *w_out, *ln1_g, *ln1_b, *w_gate, *w_up, *w_down, *ln2_g, *ln2_b;
    float* out; unsigned char* ws;
    int never; int pad_;
};

typedef const __attribute__((address_space(4))) Args CArgs;
__device__ __forceinline__ float bf2f(unsigned short b) { return __uint_as_float(((unsigned)b) << 16); }
__device__ __forceinline__ float bflo(unsigned w) { return __uint_as_float(w << 16); }
__device__ __forceinline__ float bfhi(unsigned w) { return __uint_as_float(w & 0xffff0000u); }
__device__ __forceinline__ unsigned pk(float lo, float hi) { return pg8::cvt_pk_bf16(lo, hi); }
__device__ __forceinline__ float wave_sum(float v) {
#pragma unroll
    for (int o = 32; o > 0; o >>= 1) v += __shfl_xor(v, o);
    return v;
}
__device__ __forceinline__ float sigmoidf_(float z) { return __builtin_amdgcn_rcpf(1.0f + __expf(-z)); }
__device__ __forceinline__ float gelu_tanh(float x) { const float z = 1.5957691216057308f * (x + 0.044715f * x * x * x); return x * sigmoidf_(z); }

struct RowMap { int mode;
    __device__ __forceinline__ int operator()(int n) const { return mode == 0 ? n : ((n >> 7) << 8) + (n & 127) + (mode == 2 ? 128 : 0); } };
struct TileDesc { const float* src; int ld, k0, n0; bf16_t* dst; int ldd; RowMap rm; const float* kscale; };
__device__ __forceinline__ void tile_load(const TileDesc& d, f32x4 (&v)[8]) {
    const int tid = tid_(), row = tid >> 6, c4 = (tid & 63) * 4;
#pragma unroll
    for (int i = 0; i < 8; ++i) v[i] = __builtin_nontemporal_load((const f32x4*)(d.src + (size_t)(d.k0 + row + 8 * i) * d.ld + d.n0 + c4));
}
__device__ __forceinline__ void tile_lds(const TileDesc& d, f32x4 (&v)[8], float* T) {
    const int tid = tid_(), row = tid >> 6, c4 = (tid & 63) * 4;
    if (d.kscale) {
#pragma unroll
        for (int i = 0; i < 8; ++i) v[i] *= d.kscale[d.k0 + row + 8 * i]; }
#pragma unroll
    for (int i = 0; i < 8; ++i) *(f32x4*)(T + (row + 8 * i) * 256 + (c4 ^ (i << 3))) = v[i];
}
__device__ __forceinline__ void tile_out(const TileDesc& d, const float* T) {
    const int tid = tid_(), kq = tid & 7, kc = kq * 8;
#pragma unroll
    for (int i = 0; i < 4; ++i) { const int n = (tid >> 3) + 64 * i; const float* t = T + kc * 256 + (n ^ (kq << 3));
        u32x4 w; w.x = pk(t[0], t[256]); w.y = pk(t[512], t[768]); w.z = pk(t[1024], t[1280]); w.w = pk(t[1536], t[1792]);
        __builtin_nontemporal_store(w, (u32x4*)(d.dst + (size_t)d.rm(d.n0 + n) * d.ldd + d.k0 + kc)); }
}
__device__ __forceinline__ void tile_store(const TileDesc& d, f32x4 (&v)[8], float* T) { tile_lds(d, v, T); __syncthreads(); tile_out(d, T); __syncthreads(); }
__device__ __forceinline__ void transpose_tile(const float* __restrict__ src, int ld, int k0, int n0, bf16_t* __restrict__ dst, int ldd, RowMap drow, float* T, const float* kscale = nullptr) {
    TileDesc d; d.src = src; d.ld = ld; d.k0 = k0; d.n0 = n0; d.dst = dst; d.ldd = ldd; d.rm = drow; d.kscale = kscale;
    f32x4 v[8]; tile_load(d, v); tile_store(d, v, T);
}

__device__ __forceinline__ void ln_row_stats(const f32x4 (&v)[8], float& mean, float& rstd) {
    float s = 0.f;
#pragma unroll
    for (int i = 0; i < 8; ++i) s += v[i][0] + v[i][1] + v[i][2] + v[i][3];
    mean = wave_sum(s) * (1.0f / 2048.0f);
    float q = 0.f;
#pragma unroll
    for (int i = 0; i < 8; ++i) {
#pragma unroll
        for (int j = 0; j < 4; ++j) { const float d = v[i][j] - mean; q += d * d; } }
    rstd = rsqrtf(wave_sum(q) * (1.0f / 2048.0f) + 1e-5f);
}

__device__ __forceinline__ void ssm_precompute(CArgs& a, int g, int qtr, unsigned char* smem) {
    float* Apr = (float*)smem;
    float* Api = Apr + 17 * 64;
    float* Bbr = Api + 17 * 64;
    float* Bbi = Bbr + 1024;
    float* Cr = Bbi + 1024;
    float* Ci = Cr + 1024;
    float* Km = Ci + 1024;
    float* Fr = Km + 4096;
    float* Fi = Fr + 64;
    float* Crt = Fi + 64;
    float* Cit = Crt + 1024;
    const int tid = tid_();
    float cr_[2], ci_[2], br_[2], bi_[2];
#pragma unroll
    for (int k = 0; k < 2; ++k) { const int i = tid + k * 512; cr_[k] = a.c_re[g * 1024 + i]; ci_[k] = a.c_im[g * 1024 + i]; br_[k] = a.b_re[g * 1024 + i]; bi_[k] = a.b_im[g * 1024 + i]; }
    const float twopi = 6.283185307179586f, inv2pi = 0.15915494309189535f;
    const float dt = expf(a.log_dt[g]);
    for (int i = tid; i < 17 * 64 + 64; i += 512) {
        const int p = i & 63, d = i >> 6;
        const float are = a.a_re[g * 64 + p], aim = a.a_im[g * 64 + p];
        if (d <= 16) {
            const float mag = expf((float)d * dt * are);
            float ang = (float)d * dt * aim;
            ang = fmaf(-twopi, rintf(ang * inv2pi), ang);
            const float sn = sinf(ang), cs = cosf(ang);
            Apr[d * 64 + p] = mag * cs;
            Api[d * 64 + p] = mag * sn;
        } else {
            const float mag = expf(dt * are); float ang = dt * aim; ang = fmaf(-twopi, rintf(ang * inv2pi), ang);
            const float sn = sinf(ang), c = cosf(ang);
            const float h = sinf(0.5f * ang);
            const float nre = expm1f(dt * are) * c - 2.f * h * h, nim = mag * sn;
            const float den = are * are + aim * aim;
            Fr[p] = (nre * are + nim * aim) / den;
            Fi[p] = (nim * are - nre * aim) / den;
        }
    }
#pragma unroll
    for (int k = 0; k < 2; ++k) { const int i = tid + k * 512; Cr[i] = cr_[k]; Ci[i] = ci_[k]; Crt[(i & 63) * 16 + (i >> 6)] = cr_[k]; Cit[(i & 63) * 16 + (i >> 6)] = ci_[k]; }
    __syncthreads();
#pragma unroll
    for (int k = 0; k < 2; ++k) { const int i = tid + k * 512, p = i >> 4; const float fr = Fr[p], fi = Fi[p];
        Bbr[i] = fr * br_[k] - fi * bi_[k]; Bbi[i] = fr * bi_[k] + fi * br_[k]; }
    __syncthreads();
    {
        const int d = tid >> 5, c = (tid >> 1) & 15, cb = (tid & 1) * 8;
        float acc[8];
#pragma unroll
        for (int j = 0; j < 8; ++j) acc[j] = 0.f;
        for (int p = 0; p < 64; ++p) {
            const float cr = Crt[p * 16 + c], ci = Cit[p * 16 + c], ar = Apr[d * 64 + p], ai = Api[d * 64 + p];
            const float xr = cr * ar - ci * ai, xi = cr * ai + ci * ar;
            const f32x4 b0 = *(const f32x4*)(Bbr + p * 16 + cb), b1 = *(const f32x4*)(Bbr + p * 16 + cb + 4), e0 = *(const f32x4*)(Bbi + p * 16 + cb), e1 = *(const f32x4*)(Bbi + p * 16 + cb + 4);
#pragma unroll
            for (int j = 0; j < 4; ++j) { acc[j] += xr * b0[j] - xi * e0[j]; acc[4 + j] += xr * b1[j] - xi * e1[j]; }
        }
#pragma unroll
        for (int j = 0; j < 8; ++j) Km[(d * 16 + c) * 16 + cb + j] = acc[j];
    }
    __syncthreads();
    bf16_t* ME = (bf16_t*)(a.ws + OFF_SSMME) + (size_t)g * 256 * 384;
    for (int ch = qtr * 64 * 48 + tid; ch < (qtr + 1) * 64 * 48; ch += 512) {
        const int row = ch / 48, kc = (ch % 48) * 8, t = row >> 4, c = row & 15;
        float v[8];
        if (kc < 256) { const int j = kc >> 4, c0 = kc & 15;
#pragma unroll
            for (int e = 0; e < 8; ++e) v[e] = (j <= t) ? Km[((t - j) * 16 + c) * 16 + c0 + e] : 0.f;
        } else { const bool im = kc >= 320; const int p0 = kc - (im ? 320 : 256);
#pragma unroll
            for (int e = 0; e < 8; ++e) { const int p = p0 + e; const float cr = Cr[c * 64 + p], ci = Ci[c * 64 + p], ar = Apr[(t + 1) * 64 + p], ai = Api[(t + 1) * 64 + p];
                v[e] = im ? -(cr * ai + ci * ar) : (cr * ar - ci * ai); } }
        u32x4 w; w.x = pk(v[0], v[1]); w.y = pk(v[2], v[3]); w.z = pk(v[4], v[5]); w.w = pk(v[6], v[7]);
        *(u32x4*)(ME + (size_t)row * 384 + kc) = w;
    }
    bf16_t* FT = (bf16_t*)(a.ws + OFF_SSMF) + (size_t)g * 128 * 256;
    for (int ch = qtr * 32 * 32 + tid; ch < (qtr + 1) * 32 * 32; ch += 512) {
        const int row = ch >> 5, kc = (ch & 31) * 8, im = row >> 6, p = row & 63, j = kc >> 4, c0 = kc & 15;
        const float ar = Apr[(15 - j) * 64 + p], ai = Api[(15 - j) * 64 + p];
        float v[8];
#pragma unroll
        for (int e = 0; e < 8; ++e) { const float br = Bbr[p * 16 + c0 + e], bi = Bbi[p * 16 + c0 + e]; v[e] = im ? (ar * bi + ai * br) : (ar * br - ai * bi); }
        u32x4 w; w.x = pk(v[0], v[1]); w.y = pk(v[2], v[3]); w.z = pk(v[4], v[5]); w.w = pk(v[6], v[7]);
        *(u32x4*)(FT + (size_t)row * 256 + kc) = w;
    }
    float* SC = (float*)(a.ws + OFF_SSMC) + (size_t)g * 2304;
    if (qtr == 0 && tid < 64) { SC[tid] = Apr[64 + tid]; SC[64 + tid] = Api[64 + tid]; SC[128 + tid] = Apr[16 * 64 + tid]; SC[192 + tid] = Api[16 * 64 + tid]; }
    if (qtr == 0) for (int i = tid; i < 1024; i += 512) { SC[256 + i] = Bbr[i]; SC[1280 + i] = Bbi[i]; }
    __syncthreads();
}

__device__ __forceinline__ void ln0_rows(CArgs& a, int rg, int wid, int lane) {
    const int r = rg * 8 + wid;
    bf16_t* X = (bf16_t*)(a.ws + OFF_X) + (size_t)r * D;
    if (r >= MA) {
#pragma unroll
        for (int i = 0; i < 8; ++i) *(u32x2*)(X + i * 256 + lane * 4) = (u32x2){0u, 0u};
        return; }
    const float* src = r < 8192 ? a.x_prompt + (size_t)r * D : (r < META0 ? a.x_sample + (size_t)(r - 8192) * D : a.meta + (size_t)(r - META0) * D);
    f32x4 v[8];
#pragma unroll
    for (int i = 0; i < 8; ++i) v[i] = __builtin_nontemporal_load((const f32x4*)(src + i * 256 + lane * 4));
    f32x4 gg[8], bb[8];
#pragma unroll
    for (int i = 0; i < 8; ++i) { gg[i] = *(const f32x4*)(a.ln0_g + i * 256 + lane * 4); bb[i] = *(const f32x4*)(a.ln0_b + i * 256 + lane * 4); }
    float mean, rstd; ln_row_stats(v, mean, rstd);
#pragma unroll
    for (int i = 0; i < 8; ++i) { const f32x4 y = (v[i] - mean) * rstd * gg[i] + bb[i];
        *(u32x2*)(X + i * 256 + lane * 4) = (u32x2){pk(y[0], y[1]), pk(y[2], y[3])}; }
}

__device__ __forceinline__ void phase_prep(CArgs& a, unsigned char* smem, int mask = 7) {
    const int tid = tid_(), wid = tid >> 6, lane = tid & 63;
    { const int gi = blockIdx.x * 512 + tid; if (gi < MPAD) ((float*)(a.ws + OFF_ROWSQ))[gi] = 0.f; }
    constexpr int N_SSM = 256, N_LN = MPAD / 8, T_WIN = 32 * 16, T_WGLU = 16 * 4;
    constexpr int N_ITEMS = N_SSM + N_LN + T_WIN + T_WGLU;
    for (int it = blockIdx.x; it < N_ITEMS; it += gridDim.x) {
        if (it < N_SSM) { if (mask & 1) ssm_precompute(a, it >> 2, it & 3, smem); continue; }
        int j = it - N_SSM;
        if (j < N_LN) { if (mask & 2) ln0_rows(a, j, wid, lane); continue; }
        if (!(mask & 4)) continue;
        j -= N_LN;
        float* T = (float*)smem;
        if (j < T_WIN) { transpose_tile(a.w_in, DPROJ, (j >> 4) * 64, (j & 15) * 256, (bf16_t*)(a.ws + OFF_WIN), 2048, RowMap{0}, T); continue; }
        j -= T_WIN;
        transpose_tile(a.w_glu, 1024, (j >> 2) * 64, (j & 3) * 256, (bf16_t*)(a.ws + OFF_WGLU), 1024, RowMap{0}, T);
    }
}
__device__ __forceinline__ TileDesc side_desc(CArgs& a, int kind, int j) {
    constexpr int T_G = 32 * 22;
    TileDesc d; d.kscale = nullptr;
    if (kind == 1) { d.src = a.w_down; d.ld = 2048; d.k0 = (j >> 3) * 64; d.n0 = (j & 7) * 256; d.dst = (bf16_t*)(a.ws + OFF_WDT); d.ldd = DFF; d.rm = RowMap{0}; return d; }
    if (j < 2 * T_G) { const bool up = j >= T_G; const int jj = up ? j - T_G : j; const int kt = jj / 22, nt = jj % 22;
        d.src = up ? a.w_up : a.w_gate; d.ld = DFF; d.k0 = kt * 64; d.n0 = nt * 256; d.dst = (bf16_t*)(a.ws + OFF_WGU); d.ldd = 2048; d.rm = RowMap{up ? 2 : 1}; return d; }
    const int jj = j - 2 * T_G;
    d.src = a.w_out; d.ld = 2048; d.k0 = (jj >> 3) * 64; d.n0 = (jj & 7) * 256; d.dst = (bf16_t*)(a.ws + OFF_WOUT); d.ldd = 2048; d.rm = RowMap{0}; d.kscale = d.k0 < 1024 ? a.g_ssm : nullptr; return d;
}
__device__ __forceinline__ void side_run(CArgs& a, int kind, int j0, int jend, int step, float* T) {
    for (int j = j0; j < jend; j += 2 * step) {
        const bool two = j + step < jend;
        const TileDesc dA = side_desc(a, kind, j), dB = side_desc(a, kind, two ? j + step : j);
        f32x4 vA[8], vB[8];
        tile_load(dA, vA);
        if (two) tile_load(dB, vB);
        tile_lds(dA, vA, T);
        if (two) tile_lds(dB, vB, T + 64 * 256);
        __syncthreads();
        tile_out(dA, T);
        if (two) tile_out(dB, T + 64 * 256);
        __syncthreads();
    }
}
__device__ __forceinline__ void side_transposes(CArgs& a, unsigned char* smem, int kind, int nunits, int busy_tiles) {
    const int G = (int)gridDim.x, rem = nunits % G, c = (int)blockIdx.x;
    constexpr int T_G = 32 * 22, T_WOUT = 32 * 8, T_WD = 88 * 8;
    const int total = kind == 0 ? 2 * T_G + T_WOUT : T_WD;
    float* T = (float*)smem;
    if (rem == 0) { side_run(a, kind, c, total, G, T); return; }
    const int n_idle = total - busy_tiles;
    if (c >= rem) side_run(a, kind, c - rem, n_idle, G - rem, T);
    else side_run(a, kind, n_idle + c, total, rem, T);
}

struct EpiProj { static constexpr bool PERM = true, AFTER_DRAIN = false, HAS_MID = false; bf16_t* O; int ldc; float* slab; bf16_t* ubuf;
    __device__ __forceinline__ void operator()(const f32x4 (&acc)[2][2][4][2], const pg8::Unit& u, int wr, int wc, int fr, int fq) const {
        const int col0 = u.pn * 256 + wc * 32 + 8 * fq;
        if (u.tail) {
            float* SL = slab + (size_t)(u.tail - 1) * 144 * DPROJ;
#pragma unroll
            for (int ai = 0; ai < 2; ++ai)
#pragma unroll
                for (int m = 0; m < 4; ++m) { const int rl = ai * 128 + wr * 64 + m * 16 + fr;
                    if (rl < 144) {
#pragma unroll
                        for (int bj = 0; bj < 2; ++bj) { float* p = SL + (size_t)rl * DPROJ + col0 + bj * 128; *(f32x4*)p = acc[ai][bj][m][0]; *(f32x4*)(p + 4) = acc[ai][bj][m][1]; } } }
            return; }
        const int row0 = u.pm * 256 + wr * 64 + fr;
        if (u.pn < 4) {
#pragma unroll
            for (int ai = 0; ai < 2; ++ai)
#pragma unroll
                for (int m = 0; m < 4; ++m) { const int row = row0 + ai * 128 + m * 16, n = row >> 11, tp = row & 2047;
#pragma unroll
                    for (int bj = 0; bj < 2; ++bj) { const int col = col0 + bj * 128; const f32x4 v0 = acc[ai][bj][m][0], v1 = acc[ai][bj][m][1];
                        u32x4 w; w.x = pk(v0[0], v0[1]); w.y = pk(v0[2], v0[3]); w.z = pk(v1[0], v1[1]); w.w = pk(v1[2], v1[3]);
                        *(u32x4*)(ubuf + ((size_t)(n * 64 + (col >> 4)) * 2048 + tp) * 16 + (col & 15)) = w; } }
            return; }
#pragma unroll
        for (int ai = 0; ai < 2; ++ai)
#pragma unroll
            for (int m = 0; m < 4; ++m) { bf16_t* rowp = O + (size_t)(row0 + ai * 128 + m * 16) * ldc + col0;
#pragma unroll
                for (int bj = 0; bj < 2; ++bj) { const f32x4 v0 = acc[ai][bj][m][0], v1 = acc[ai][bj][m][1];
                    u32x4 w; w.x = pk(v0[0], v0[1]); w.y = pk(v0[2], v0[3]); w.z = pk(v1[0], v1[1]); w.w = pk(v1[2], v1[3]);
                    *(u32x4*)(rowp + bj * 128) = w; } }
    }
};
struct EpiGlu { static constexpr bool PERM = true, AFTER_DRAIN = false, HAS_MID = false; const bf16_t* Y; bf16_t* O; float* rowsq;
    __device__ __forceinline__ void operator()(const f32x4 (&acc)[2][2][4][2], const pg8::Unit& u, int wr, int wc, int fr, int fq) const {
        const int row0 = u.pm * 256 + wr * 64 + fr, col0 = u.pn * 256 + wc * 32 + 8 * fq;
#pragma unroll
        for (int ai = 0; ai < 2; ++ai) {
            u32x4 yv[4][2];
#pragma unroll
            for (int m = 0; m < 4; ++m)
#pragma unroll
                for (int bj = 0; bj < 2; ++bj) yv[m][bj] = *(const u32x4*)(Y + (size_t)(row0 + ai * 128 + m * 16) * 1024 + col0 + bj * 128);
#pragma unroll
            for (int m = 0; m < 4; ++m) { const int row = row0 + ai * 128 + m * 16; float ss = 0.f;
#pragma unroll
                for (int bj = 0; bj < 2; ++bj) { const f32x4 z0 = acc[ai][bj][m][0], z1 = acc[ai][bj][m][1]; const u32x4 y = yv[m][bj];
                    float o[8];
                    o[0] = bflo(y.x) * sigmoidf_(z0[0]); o[1] = bfhi(y.x) * sigmoidf_(z0[1]); o[2] = bflo(y.y) * sigmoidf_(z0[2]); o[3] = bfhi(y.y) * sigmoidf_(z0[3]);
                    o[4] = bflo(y.z) * sigmoidf_(z1[0]); o[5] = bfhi(y.z) * sigmoidf_(z1[1]); o[6] = bflo(y.w) * sigmoidf_(z1[2]); o[7] = bfhi(y.w) * sigmoidf_(z1[3]);
#pragma unroll
                    for (int e = 0; e < 8; ++e) ss += o[e] * o[e];
                    u32x4 w; w.x = pk(o[0], o[1]); w.y = pk(o[2], o[3]); w.z = pk(o[4], o[5]); w.w = pk(o[6], o[7]);
                    *(u32x4*)(O + (size_t)row * 2048 + col0 + bj * 128) = w; }
                ss += __shfl_xor(ss, 16); ss += __shfl_xor(ss, 32);
                if (fq == 0 && row < MROWS) atomicAdd(rowsq + row, ss); }
        }
    }
};
__device__ __forceinline__ float rms_scale(const float* rowsq, int row) { return rsqrtf(rowsq[row] * (1.0f / 1024.0f) + 1e-6f); }
template <bool MID> struct EpiRes { static constexpr bool PERM = true, AFTER_DRAIN = false, HAS_MID = MID; const bf16_t* X; bf16_t* Z; float* slab; const float* rowsq; int mid_t;
    __device__ __forceinline__ void mid(f32x4 (&acc)[2][2][4][2], const pg8::Unit& u, int wr, int fr) const {
        const float* rp = rowsq + (u.pm * 256 + wr * 64 + fr);
        float q[2][4];
#pragma unroll
        for (int ai = 0; ai < 2; ++ai)
#pragma unroll
            for (int m = 0; m < 4; ++m) q[ai][m] = rp[ai * 128 + m * 16];
        __builtin_amdgcn_sched_barrier(0);
#pragma unroll
        for (int ai = 0; ai < 2; ++ai)
#pragma unroll
            for (int m = 0; m < 4; ++m) { const float rs = rsqrtf(q[ai][m] * (1.0f / 1024.0f) + 1e-6f);
#pragma unroll
                for (int bj = 0; bj < 2; ++bj)
#pragma unroll
                    for (int n = 0; n < 2; ++n) acc[ai][bj][m][n] *= rs; }
    }
    __device__ __forceinline__ void operator()(const f32x4 (&acc)[2][2][4][2], const pg8::Unit& u, int wr, int wc, int fr, int fq) const {
        const int col0 = u.pn * 256 + wc * 32 + 8 * fq;
        if (u.tail) {
            float* SL = slab + (size_t)(u.tail - 1) * 128 * 2048;
            float rsv[4] = {1.0f, 1.0f, 1.0f, 1.0f};
            if (MID && (u.kt0 < mid_t)) {
#pragma unroll
                for (int m = 0; m < 4; ++m) rsv[m] = rms_scale(rowsq, 8192 + wr * 64 + m * 16 + fr); }
#pragma unroll
            for (int m = 0; m < 4; ++m) { const int rl = wr * 64 + m * 16 + fr; const float rs = rsv[m];
#pragma unroll
                for (int bj = 0; bj < 2; ++bj) { float* p = SL + (size_t)rl * 2048 + col0 + bj * 128; *(f32x4*)p = acc[0][bj][m][0] * rs; *(f32x4*)(p + 4) = acc[0][bj][m][1] * rs; } }
            return; }
        const int row0 = u.pm * 256 + wr * 64 + fr;
#pragma unroll
        for (int ai = 0; ai < 2; ++ai) {
            u32x4 xv[4][2];
#pragma unroll
            for (int m = 0; m < 4; ++m)
#pragma unroll
                for (int bj = 0; bj < 2; ++bj) xv[m][bj] = *(const u32x4*)(X + (size_t)(row0 + ai * 128 + m * 16) * 2048 + col0 + bj * 128);
#pragma unroll
            for (int m = 0; m < 4; ++m) { const int row = row0 + ai * 128 + m * 16;
#pragma unroll
                for (int bj = 0; bj < 2; ++bj) { const u32x4 x = xv[m][bj]; const f32x4 c0 = acc[ai][bj][m][0], c1 = acc[ai][bj][m][1];
                    u32x4 w; w.x = pk(ALPHA * bflo(x.x) + c0[0], ALPHA * bfhi(x.x) + c0[1]); w.y = pk(ALPHA * bflo(x.y) + c0[2], ALPHA * bfhi(x.y) + c0[3]);
                    w.z = pk(ALPHA * bflo(x.z) + c1[0], ALPHA * bfhi(x.z) + c1[1]); w.w = pk(ALPHA * bflo(x.w) + c1[2], ALPHA * bfhi(x.w) + c1[3]);
                    *(u32x4*)(Z + (size_t)row * 2048 + col0 + bj * 128) = w; } }
        }
    }
};
struct EpiGateUp { static constexpr bool PERM = true, AFTER_DRAIN = false, HAS_MID = false; bf16_t* O;
    __device__ __forceinline__ void operator()(const f32x4 (&acc)[2][2][4][2], const pg8::Unit& u, int wr, int wc, int fr, int fq) const {
        const int row0 = u.pm * 256 + wr * 64 + fr, col0 = u.pn * 128 + wc * 32 + 8 * fq;
#pragma unroll
        for (int ai = 0; ai < 2; ++ai)
#pragma unroll
            for (int m = 0; m < 4; ++m) { const int row = row0 + ai * 128 + m * 16; float h[8];
#pragma unroll
                for (int n = 0; n < 2; ++n)
#pragma unroll
                    for (int e = 0; e < 4; ++e) { const float gt = acc[ai][0][m][n][e], up = acc[ai][1][m][n][e]; h[n * 4 + e] = gt * sigmoidf_(gt) * up; }
                u32x4 w; w.x = pk(h[0], h[1]); w.y = pk(h[2], h[3]); w.z = pk(h[4], h[5]); w.w = pk(h[6], h[7]);
                *(u32x4*)(O + (size_t)row * DFF + col0) = w; }
    }
};


struct TailOrder {
    pg8::StaticOrder so; int nmain, nN, S, ktiles, nMm;
    __device__ void init(int nMm_, int N, int ktiles_, int S_, int G, int c) { nMm = nMm_; so.init(nMm_ * 256, N, G, c); so.ktiles = ktiles_; nmain = so.nwg; nN = N / 256; S = S_; ktiles = ktiles_; }
    __device__ bool next(int i, pg8::Unit& u) const {
        const int L = i * so.G + so.c;
        if (L < nmain) return so.next(i, u);
        const int idx = L - nmain; if (idx >= nN * S) return false;
        const int s = idx / nN; u.pm = nMm; u.pn = idx - s * nN; u.nkt = ktiles / S; u.kt0 = s * u.nkt; u.tail = s + 1; return true;
    }
    __device__ __forceinline__ void a_ready(const pg8::Unit&) const {}
    __device__ __forceinline__ void done(const pg8::Unit&) const {}
};
template <class Epi, bool ALIGN = false> __device__ __forceinline__ void run_gemm(unsigned char* smem, const bf16_t* A, const bf16_t* Bt, int M, int N, int K, const Epi& E) {
    pg8::Gemm g; g.A = A; g.Bt = Bt; g.M = M; g.N = N; g.K = K;
    pg8::StaticOrder S; S.init(M, N, (int)gridDim.x, (int)blockIdx.x); S.ktiles = K / 64;
    pg8::gemm_phase<Epi, pg8::StaticOrder, false, true, ALIGN>((PG8_LAS unsigned char*)smem, g, S, E, nullptr);
}
template <class Epi> __device__ __forceinline__ void run_gemm_tail(unsigned char* smem, const bf16_t* A, const bf16_t* Bt, int N, int K, int S_, const Epi& E) {
    pg8::Gemm g; g.A = A; g.Bt = Bt; g.M = MPAD; g.N = N; g.K = K;
    TailOrder S; S.init(32, N, K / 64, S_, (int)gridDim.x, (int)blockIdx.x);
    pg8::gemm_phase<Epi, TailOrder, false, true, true>((PG8_LAS unsigned char*)smem, g, S, E, nullptr);
}

__device__ __forceinline__ void unpack8(const u32x4 v, float (&o)[8]) { o[0] = bflo(v.x); o[1] = bfhi(v.x); o[2] = bflo(v.y); o[3] = bfhi(v.y); o[4] = bflo(v.z); o[5] = bfhi(v.z); o[6] = bflo(v.w); o[7] = bfhi(v.w); }

__device__ __forceinline__ void proj8(CArgs& a, int row, int col, float (&v)[8]) { unpack8(*(const u32x4*)((const bf16_t*)(a.ws + OFF_PROJ) + (size_t)row * DPROJ + col), v); }
__device__ __forceinline__ void phase_tail_reduce(CArgs& a) {
    const int gi = blockIdx.x * 512 + tid_();
    for (int i = gi; i < 144 * 512; i += gridDim.x * 512) {
        const int rl = i >> 9, c8 = (i & 511) * 8;
        const float* SL = (const float*)(a.ws + OFF_SLAB) + (size_t)rl * DPROJ + c8;
        f32x4 s0 = *(const f32x4*)SL, s1 = *(const f32x4*)(SL + 4);
#pragma unroll
        for (int s = 1; s < S_PROJ; ++s) { s0 += *(const f32x4*)(SL + (size_t)s * 144 * DPROJ); s1 += *(const f32x4*)(SL + (size_t)s * 144 * DPROJ + 4); }
        u32x4 w; w.x = pk(s0[0], s0[1]); w.y = pk(s0[2], s0[3]); w.z = pk(s1[0], s1[1]); w.w = pk(s1[2], s1[3]);
        *(u32x4*)((bf16_t*)(a.ws + OFF_PROJ) + (size_t)(8192 + rl) * DPROJ + c8) = w;
    }
}
constexpr int USTR = 528;
__device__ __forceinline__ void ssm_item(CArgs& a, int n, int g, unsigned char* smem) {
    unsigned char* U = smem;
    unsigned char* S = smem + 144 * USTR;
    const int tid = tid_(), wid = tid >> 6, lane = tid & 63, fr = lane & 15, fq = lane >> 4;
    const bf16_t* PROJ = (const bf16_t*)(a.ws + OFF_PROJ);
    const bf16_t* UB = (const bf16_t*)a.out + (size_t)(n * 64 + g) * 2048 * 16;
    const bf16_t* FT = (const bf16_t*)(a.ws + OFF_SSMF) + (size_t)g * 128 * 256 + (size_t)(wid * 16 + fr) * 256 + fq * 8;
    bf16x8 bfr[8];
#pragma unroll
    for (int kk = 0; kk < 8; ++kk) bfr[kk] = *(const bf16x8*)(FT + kk * 32);
    {
        u32x4 v[9];
#pragma unroll
        for (int q = 0; q < 9; ++q) { const int i = tid + q * 512, ch = i >> 5, j = (i >> 1) & 15, hh = i & 1;
            v[q] = (u32x4){0u, 0u, 0u, 0u};
            if (ch == 0) v[q] = *(const u32x4*)(PROJ + (size_t)(META0 + j) * DPROJ + g * 16 + hh * 8);
            else if (ch < 129) v[q] = __builtin_nontemporal_load((const u32x4*)(UB + (size_t)(i - 32) * 8)); }
#pragma unroll
        for (int q = 0; q < 9; ++q) { const int i = tid + q * 512, ch = i >> 5, j = (i >> 1) & 15, hh = i & 1; *(u32x4*)(U + ch * USTR + j * 32 + hh * 16) = v[q]; }
    }
    __syncthreads();
    {
#pragma unroll 1
        for (int m3 = 0; m3 < 3; ++m3) {
            f32x4 acc[3];
#pragma unroll
            for (int q = 0; q < 3; ++q) acc[q] = (f32x4){0.f, 0.f, 0.f, 0.f};
#pragma unroll
            for (int kk = 0; kk < 8; ++kk)
#pragma unroll
                for (int q = 0; q < 3; ++q) { const bf16x8 av = *(const bf16x8*)(U + ((m3 * 3 + q) * 16 + fr) * USTR + (kk * 32 + fq * 8) * 2); acc[q] = __builtin_amdgcn_mfma_f32_16x16x32_bf16(av, bfr[kk], acc[q], 0, 0, 0); }
#pragma unroll
            for (int q = 0; q < 3; ++q)
#pragma unroll
                for (int j = 0; j < 4; ++j) *(float*)(S + ((m3 * 3 + q) * 16 + fq * 4 + j) * USTR + (wid * 16 + fr) * 4) = acc[q][j];
        }
    }
    const bf16_t* MEw = (const bf16_t*)(a.ws + OFF_SSMME) + (size_t)g * 256 * 384 + (size_t)(wid * 32 + fr) * 384 + fq * 8;
    bf16x8 bm0[12], bm1[12];
#pragma unroll
    for (int kk = 0; kk < 12; ++kk) { bm0[kk] = *(const bf16x8*)(MEw + kk * 32); bm1[kk] = *(const bf16x8*)(MEw + 16 * 384 + kk * 32); }
    __syncthreads();
    {
        const float* SC = (const float*)(a.ws + OFF_SSMC) + (size_t)g * 2304;
        const float ar = SC[128 + lane], ai = SC[192 + lane];
        float pr[17], pi[17];
        pr[0] = 0.f; pi[0] = 0.f;
#pragma unroll
        for (int k = 0; k < 16; ++k) { const int ch = wid * 16 + k;
            const float lr = *(const float*)(S + ch * USTR + lane * 4), li = *(const float*)(S + ch * USTR + 256 + lane * 4);
            pr[k + 1] = ar * pr[k] - ai * pi[k] + lr; pi[k + 1] = ar * pi[k] + ai * pr[k] + li; }
        const float l128r = *(const float*)(S + 128 * USTR + lane * 4), l128i = *(const float*)(S + 128 * USTR + 256 + lane * 4);
        float* E = (float*)(S + (136 + wid) * USTR);
        E[lane] = pr[16]; E[64 + lane] = pi[16];
        __syncthreads();
        float a2r = ar, a2i = ai;
#pragma unroll
        for (int q = 0; q < 4; ++q) { const float tr = a2r * a2r - a2i * a2i, ti = 2.f * a2r * a2i; a2r = tr; a2i = ti; }
        float cr = 0.f, ci = 0.f;
        for (int v = 0; v < wid; ++v) { const float* Ev = (const float*)(S + (136 + v) * USTR); const float er = Ev[lane], ei = Ev[64 + lane];
            const float tr = a2r * cr - a2i * ci + er, ti = a2r * ci + a2i * cr + ei; cr = tr; ci = ti; }
#pragma unroll
        for (int k = 0; k < 16; ++k) { const int ch = wid * 16 + k;
            *(bf16_t*)(S + ch * USTR + lane * 2) = (bf16_t)(pk(pr[k] + cr, 0.f) & 0xffffu);
            *(bf16_t*)(S + ch * USTR + 128 + lane * 2) = (bf16_t)(pk(pi[k] + ci, 0.f) & 0xffffu);
            const float tr = ar * cr - ai * ci, ti = ar * ci + ai * cr; cr = tr; ci = ti; }
        if (wid == 7) {
            const float sr = pr[16] + cr, si = pi[16] + ci;
            *(bf16_t*)(S + 128 * USTR + lane * 2) = (bf16_t)(pk(sr, 0.f) & 0xffffu);
            *(bf16_t*)(S + 128 * USTR + 128 + lane * 2) = (bf16_t)(pk(si, 0.f) & 0xffffu);
            a.out[O_PRE + (size_t)(n * 64 + g) * 64 + lane] = ar * sr - ai * si + l128r;
            a.out[O_PIM + (size_t)(n * 64 + g) * 64 + lane] = ar * si + ai * sr + l128i;
        }
    }
    __syncthreads();
    {
        const f32x4 dsk = *(const f32x4*)(a.ssm_d + g * 16 + fq * 4);
        bf16_t* YA = (bf16_t*)(a.ws + OFF_YACT);
#pragma unroll 1
        for (int mt = 0; mt < 9; ++mt) {
            f32x4 acc0 = (f32x4){0.f, 0.f, 0.f, 0.f}, acc1 = (f32x4){0.f, 0.f, 0.f, 0.f};
#pragma unroll
            for (int kk = 0; kk < 8; ++kk) if (kk <= wid) { const bf16x8 uv = *(const bf16x8*)(U + (mt * 16 + fr) * USTR + (kk * 32 + fq * 8) * 2);
                acc0 = __builtin_amdgcn_mfma_f32_16x16x32_bf16(bm0[kk], uv, acc0, 0, 0, 0); acc1 = __builtin_amdgcn_mfma_f32_16x16x32_bf16(bm1[kk], uv, acc1, 0, 0, 0); }
#pragma unroll
            for (int kk = 0; kk < 4; ++kk) { const bf16x8 sv = *(const bf16x8*)(S + (mt * 16 + fr) * USTR + (kk * 32 + fq * 8) * 2);
                acc0 = __builtin_amdgcn_mfma_f32_16x16x32_bf16(bm0[8 + kk], sv, acc0, 0, 0, 0); acc1 = __builtin_amdgcn_mfma_f32_16x16x32_bf16(bm1[8 + kk], sv, acc1, 0, 0, 0); }
            const int ch = mt * 16 + fr;
            if (ch >= 1 && ch < 129) {
#pragma unroll
                for (int ti = 0; ti < 2; ++ti) { const int t = wid * 2 + ti; const f32x4 acc = ti ? acc1 : acc0;
                    const u32x2 ur = *(const u32x2*)(U + ch * USTR + (t * 16 + fq * 4) * 2);
                    const float y0 = gelu_tanh(acc[0] + dsk[0] * bflo(ur.x)), y1 = gelu_tanh(acc[1] + dsk[1] * bfhi(ur.x)), y2 = gelu_tanh(acc[2] + dsk[2] * bflo(ur.y)), y3 = gelu_tanh(acc[3] + dsk[3] * bfhi(ur.y));
                    *(u32x2*)(YA + (size_t)(n * 2048 + (ch - 1) * 16 + t) * 1024 + g * 16 + fq * 4) = (u32x2){pk(y0, y1), pk(y2, y3)}; }
            }
        }
    }
    __syncthreads();
}

__device__ __forceinline__ void sample_ssm_quad(CArgs& a, int b0, int g, int lane) {
    const float* SC = (const float*)(a.ws + OFF_SSMC) + (size_t)g * 2304;
    const bf16_t* PROJ = (const bf16_t*)(a.ws + OFF_PROJ) + (size_t)(8192 + b0) * DPROJ + g * 16;
    u32x4 ur[4][2]; float s0r[4], s0i[4];
#pragma unroll
    for (int i = 0; i < 4; ++i) { ur[i][0] = *(const u32x4*)(PROJ + (size_t)i * DPROJ); ur[i][1] = *(const u32x4*)(PROJ + (size_t)i * DPROJ + 8);
        const size_t so = (size_t)((b0 + i) * 64 + g) * 64 + lane; s0r[i] = a.st_re[so]; s0i[i] = a.st_im[so]; }
    f32x4 br[4], bi[4], cr4[4], ci4[4];
#pragma unroll
    for (int q = 0; q < 4; ++q) { br[q] = *(const f32x4*)(SC + 256 + lane * 16 + q * 4); bi[q] = *(const f32x4*)(SC + 1280 + lane * 16 + q * 4); }
    const int c = lane & 15, qq = lane >> 4;
    { const float* crp = a.c_re + (size_t)(g * 16 + c) * 64 + qq * 16; const float* cip = a.c_im + (size_t)(g * 16 + c) * 64 + qq * 16;
#pragma unroll
      for (int k = 0; k < 4; ++k) { cr4[k] = *(const f32x4*)(crp + 4 * k); ci4[k] = *(const f32x4*)(cip + 4 * k); } }
    const float ar = SC[lane], ai = SC[64 + lane], dsk = a.ssm_d[g * 16 + c];
#pragma unroll
    for (int i = 0; i < 4; ++i) {
        float uu[16]; { float f[8]; unpack8(ur[i][0], f);
#pragma unroll
            for (int e = 0; e < 8; ++e) uu[e] = f[e];
            unpack8(ur[i][1], f);
#pragma unroll
            for (int e = 0; e < 8; ++e) uu[8 + e] = f[e]; }
        float xr = 0.f, xi = 0.f;
#pragma unroll
        for (int q = 0; q < 4; ++q)
#pragma unroll
            for (int e = 0; e < 4; ++e) { xr += br[q][e] * uu[q * 4 + e]; xi += bi[q][e] * uu[q * 4 + e]; }
        const float sr = ar * s0r[i] - ai * s0i[i] + xr, si = ar * s0i[i] + ai * s0r[i] + xi;
        const size_t so = (size_t)((b0 + i) * 64 + g) * 64 + lane;
        a.out[O_SRE + so] = sr; a.out[O_SIM + so] = si;
        float part = 0.f;
#pragma unroll
        for (int k = 0; k < 16; ++k) { const float spr = __shfl(sr, qq * 16 + k), spi = __shfl(si, qq * 16 + k); part += cr4[k >> 2][k & 3] * spr - ci4[k >> 2][k & 3] * spi; }
        part += __shfl_xor(part, 16); part += __shfl_xor(part, 32);
        float uc = 0.f;
#pragma unroll
        for (int e = 0; e < 16; ++e) uc = (c == e) ? uu[e] : uc;
        const float y = gelu_tanh(part + dsk * uc);
        if (lane < 16) ((bf16_t*)(a.ws + OFF_YACT))[(size_t)(8192 + b0 + i) * 1024 + g * 16 + lane] = (bf16_t)(pk(y, 0.f) & 0xffffu);
    }
}

__device__ __forceinline__ void load_v8(CArgs& a, int row, int j, float (&v)[8]) {
    float c[8], h[8]; proj8(a, row, 2048 + j, c); proj8(a, row, 3072 + j, h);
#pragma unroll
    for (int e = 0; e < 8; ++e) v[e] = c[e] * h[e];
}
__device__ __forceinline__ void conv_row(CArgs& a, int r, int lane) {
    float y[2][8], vcur[2][8]; float ss = 0.f;
    f32x4 q1[2][2], gv[2][2];
    const bool smp = r >= 8192;
#pragma unroll
    for (int hh = 0; hh < 2; ++hh) {
        const int j = hh * 512 + lane * 8;
        float v1[8], v2[8], bg[8];
        load_v8(a, r, j, vcur[hh]);
        proj8(a, r, 1024 + j, bg);
        if (!smp) { const int tp = r & 2047; const int r1 = tp >= 1 ? r - 1 : META0 + 15, r2 = tp >= 2 ? r - 2 : META0 + 14 + tp;
            load_v8(a, r1, j, v1); load_v8(a, r2, j, v2);
        } else { const float* sc = a.st_conv + (size_t)(r - 8192) * 2048 + j;
            const f32x4 p0 = *(const f32x4*)sc, p1 = *(const f32x4*)(sc + 4); q1[hh][0] = *(const f32x4*)(sc + 1024); q1[hh][1] = *(const f32x4*)(sc + 1028);
#pragma unroll
            for (int e = 0; e < 4; ++e) { v2[e] = p0[e]; v2[4 + e] = p1[e]; v1[e] = q1[hh][0][e]; v1[4 + e] = q1[hh][1][e]; } }
        const f32x4 w0a = *(const f32x4*)(a.conv_w + j), w0b = *(const f32x4*)(a.conv_w + j + 4), w1a = *(const f32x4*)(a.conv_w + 1024 + j), w1b = *(const f32x4*)(a.conv_w + 1024 + j + 4),
                    w2a = *(const f32x4*)(a.conv_w + 2048 + j), w2b = *(const f32x4*)(a.conv_w + 2048 + j + 4);
        gv[hh][0] = *(const f32x4*)(a.g_conv + j); gv[hh][1] = *(const f32x4*)(a.g_conv + j + 4);
#pragma unroll
        for (int e = 0; e < 8; ++e) { const float w0 = e < 4 ? w0a[e & 3] : w0b[e & 3], w1 = e < 4 ? w1a[e & 3] : w1b[e & 3], w2 = e < 4 ? w2a[e & 3] : w2b[e & 3];
            const float cv = w0 * v2[e] + w1 * v1[e] + w2 * vcur[hh][e]; y[hh][e] = bg[e] * cv; ss += y[hh][e] * y[hh][e]; }
    }
    const float rr = rsqrtf(wave_sum(ss) * (1.0f / 1024.0f) + 1e-6f);
    bf16_t* MG = (bf16_t*)(a.ws + OFF_MERGED) + (size_t)r * 2048 + 1024;
#pragma unroll
    for (int hh = 0; hh < 2; ++hh) { const int j = hh * 512 + lane * 8; const f32x4 ga = gv[hh][0], gb = gv[hh][1];
        u32x4 w; w.x = pk(y[hh][0] * rr * ga[0], y[hh][1] * rr * ga[1]); w.y = pk(y[hh][2] * rr * ga[2], y[hh][3] * rr * ga[3]); w.z = pk(y[hh][4] * rr * gb[0], y[hh][5] * rr * gb[1]); w.w = pk(y[hh][6] * rr * gb[2], y[hh][7] * rr * gb[3]);
        *(u32x4*)(MG + j) = w;
        if (smp) { float* o = a.out + O_SCV + (size_t)(r - 8192) * 2048 + j; *(f32x4*)o = q1[hh][0]; *(f32x4*)(o + 4) = q1[hh][1];
            *(f32x4*)(o + 1024) = (f32x4){vcur[hh][0], vcur[hh][1], vcur[hh][2], vcur[hh][3]}; *(f32x4*)(o + 1028) = (f32x4){vcur[hh][4], vcur[hh][5], vcur[hh][6], vcur[hh][7]}; } }
}
template <int NR> __device__ __forceinline__ void conv_rows(CArgs& a, int r0, int lane) {
    const int tp0 = r0 & 2047;
    const bf16_t* PR = (const bf16_t*)(a.ws + OFF_PROJ) + (size_t)(r0 - 2) * DPROJ;
    float y[NR][2][8]; float ss[NR];
#pragma unroll
    for (int i = 0; i < NR; ++i) ss[i] = 0.f;
#pragma unroll
    for (int hh = 0; hh < 2; ++hh) {
        const int j = hh * 512 + lane * 8;
        float v[NR + 2][8], bg[NR][8];
        {
            u32x4 cc[NR + 2], hv[NR + 2], bb[NR];
#pragma unroll
            for (int i = 0; i < NR + 2; ++i) { cc[i] = *(const u32x4*)(PR + (size_t)i * DPROJ + 2048 + j); hv[i] = *(const u32x4*)(PR + (size_t)i * DPROJ + 3072 + j); }
#pragma unroll
            for (int i = 0; i < NR; ++i) bb[i] = *(const u32x4*)(PR + (size_t)(i + 2) * DPROJ + 1024 + j);
#pragma unroll
            for (int i = 0; i < NR + 2; ++i) { float c[8], h[8]; unpack8(cc[i], c); unpack8(hv[i], h);
#pragma unroll
                for (int e = 0; e < 8; ++e) v[i][e] = c[e] * h[e]; }
#pragma unroll
            for (int i = 0; i < NR; ++i) unpack8(bb[i], bg[i]);
        }
        const f32x4 w0a = *(const f32x4*)(a.conv_w + j), w0b = *(const f32x4*)(a.conv_w + j + 4), w1a = *(const f32x4*)(a.conv_w + 1024 + j), w1b = *(const f32x4*)(a.conv_w + 1024 + j + 4),
                    w2a = *(const f32x4*)(a.conv_w + 2048 + j), w2b = *(const f32x4*)(a.conv_w + 2048 + j + 4);
        if (tp0 + NR == 2048) {
#pragma unroll
            for (int i = NR - 2; i < NR; ++i) { float* o = a.out + O_PCV + (size_t)((r0 >> 11) * 2 + (i - (NR - 2))) * 1024 + j; *(f32x4*)o = (f32x4){v[2 + i][0], v[2 + i][1], v[2 + i][2], v[2 + i][3]}; *(f32x4*)(o + 4) = (f32x4){v[2 + i][4], v[2 + i][5], v[2 + i][6], v[2 + i][7]}; } }
#pragma unroll
        for (int i = 0; i < NR; ++i)
#pragma unroll
            for (int e = 0; e < 8; ++e) { const float w0 = e < 4 ? w0a[e & 3] : w0b[e & 3], w1 = e < 4 ? w1a[e & 3] : w1b[e & 3], w2 = e < 4 ? w2a[e & 3] : w2b[e & 3];
                const float cv = w0 * v[i][e] + w1 * v[i + 1][e] + w2 * v[i + 2][e]; const float yy = bg[i][e] * cv; y[i][hh][e] = yy; ss[i] += yy * yy; }
    }
#pragma unroll
    for (int i = 0; i < NR; ++i) {
        const float rr = rsqrtf(wave_sum(ss[i]) * (1.0f / 1024.0f) + 1e-6f);
        bf16_t* MG = (bf16_t*)(a.ws + OFF_MERGED) + (size_t)(r0 + i) * 2048 + 1024;
#pragma unroll
        for (int hh = 0; hh < 2; ++hh) { const int j = hh * 512 + lane * 8; const f32x4 ga = *(const f32x4*)(a.g_conv + j), gb = *(const f32x4*)(a.g_conv + j + 4);
            u32x4 w; w.x = pk(y[i][hh][0] * rr * ga[0], y[i][hh][1] * rr * ga[1]); w.y = pk(y[i][hh][2] * rr * ga[2], y[i][hh][3] * rr * ga[3]);
            w.z = pk(y[i][hh][4] * rr * gb[0], y[i][hh][5] * rr * gb[1]); w.w = pk(y[i][hh][6] * rr * gb[2], y[i][hh][7] * rr * gb[3]);
            *(u32x4*)(MG + j) = w; }
    }
}

__device__ __forceinline__ void conv_rows4_lds(CArgs& a, int r0, int lane, float* Y) {
    const int tp0 = r0 & 2047;
    const bf16_t* PR = (const bf16_t*)(a.ws + OFF_PROJ) + (size_t)(r0 - 2) * DPROJ;
    float ss[4] = {0.f, 0.f, 0.f, 0.f};
#pragma unroll
    for (int hh = 0; hh < 2; ++hh) {
        const int j = hh * 512 + lane * 8;
        float v[6][8], bg[4][8];
        {
            u32x4 cc[6], hv[6], bb[4];
#pragma unroll
            for (int i = 0; i < 6; ++i) { cc[i] = __builtin_nontemporal_load((const u32x4*)(PR + (size_t)i * DPROJ + 2048 + j)); hv[i] = __builtin_nontemporal_load((const u32x4*)(PR + (size_t)i * DPROJ + 3072 + j)); }
#pragma unroll
            for (int i = 0; i < 4; ++i) bb[i] = __builtin_nontemporal_load((const u32x4*)(PR + (size_t)(i + 2) * DPROJ + 1024 + j));
#pragma unroll
            for (int i = 0; i < 6; ++i) { float c[8], h[8]; unpack8(cc[i], c); unpack8(hv[i], h);
#pragma unroll
                for (int e = 0; e < 8; ++e) v[i][e] = c[e] * h[e]; }
#pragma unroll
            for (int i = 0; i < 4; ++i) unpack8(bb[i], bg[i]);
        }
        const f32x4 w0a = *(const f32x4*)(a.conv_w + j), w0b = *(const f32x4*)(a.conv_w + j + 4), w1a = *(const f32x4*)(a.conv_w + 1024 + j), w1b = *(const f32x4*)(a.conv_w + 1024 + j + 4),
                    w2a = *(const f32x4*)(a.conv_w + 2048 + j), w2b = *(const f32x4*)(a.conv_w + 2048 + j + 4);
        if (tp0 == 2044) {
#pragma unroll
            for (int i = 2; i < 4; ++i) { float* o = a.out + O_PCV + (size_t)((r0 >> 11) * 2 + (i - 2)) * 1024 + j; *(f32x4*)o = (f32x4){v[2 + i][0], v[2 + i][1], v[2 + i][2], v[2 + i][3]}; *(f32x4*)(o + 4) = (f32x4){v[2 + i][4], v[2 + i][5], v[2 + i][6], v[2 + i][7]}; } }
#pragma unroll
        for (int i = 0; i < 4; ++i) { f32x4 y0, y1;
#pragma unroll
            for (int e = 0; e < 8; ++e) { const float w0 = e < 4 ? w0a[e & 3] : w0b[e & 3], w1 = e < 4 ? w1a[e & 3] : w1b[e & 3], w2 = e < 4 ? w2a[e & 3] : w2b[e & 3];
                const float yy = bg[i][e] * (w0 * v[i][e] + w1 * v[i + 1][e] + w2 * v[i + 2][e]); ss[i] += yy * yy; if (e < 4) y0[e & 3] = yy; else y1[e & 3] = yy; }
            float* yp = Y + ((i * 2 + hh) * 64 + lane) * 8; *(f32x4*)yp = y0; *(f32x4*)(yp + 4) = y1; }
    }
    f32x4 gv[2][2];
#pragma unroll
    for (int hh = 0; hh < 2; ++hh) { gv[hh][0] = *(const f32x4*)(a.g_conv + hh * 512 + lane * 8); gv[hh][1] = *(const f32x4*)(a.g_conv + hh * 512 + lane * 8 + 4); }
#pragma unroll
    for (int i = 0; i < 4; ++i) {
        const float rr = rsqrtf(wave_sum(ss[i]) * (1.0f / 1024.0f) + 1e-6f);
        bf16_t* MG = (bf16_t*)(a.ws + OFF_MERGED) + (size_t)(r0 + i) * 2048 + 1024;
#pragma unroll
        for (int hh = 0; hh < 2; ++hh) { const int j = hh * 512 + lane * 8; const f32x4 ga = gv[hh][0], gb = gv[hh][1];
            const float* yp = Y + ((i * 2 + hh) * 64 + lane) * 8; const f32x4 y0 = *(const f32x4*)yp, y1 = *(const f32x4*)(yp + 4);
            u32x4 w; w.x = pk(y0[0] * rr * ga[0], y0[1] * rr * ga[1]); w.y = pk(y0[2] * rr * ga[2], y0[3] * rr * ga[3]); w.z = pk(y1[0] * rr * gb[0], y1[1] * rr * gb[1]); w.w = pk(y1[2] * rr * gb[2], y1[3] * rr * gb[3]);
            *(u32x4*)(MG + j) = w; }
    }
}

__device__ __forceinline__ void phase_mixers(CArgs& a, unsigned char* smem, int mask = 7) {
    const int tid = tid_(), wid = tid >> 6, lane = tid & 63;
    if (mask & 1) for (int it = blockIdx.x; it < 256; it += gridDim.x) ssm_item(a, it >> 6, it & 63, smem);
    const int gw = blockIdx.x * 8 + wid, nw = gridDim.x * 8;
    if (mask & 2) for (int it = gw; it < 32 * 64; it += nw) sample_ssm_quad(a, (it >> 6) * 4, it & 63, lane);
    if (mask & 4) {
        for (int t = gw; t < 2048; t += nw) if ((t & 511) != 0) conv_rows4_lds(a, t * 4, lane, (float*)(smem + wid * 16384));
        const int sstr = nw / 144;
        if (sstr >= 1) { if (gw % sstr == 0 && gw / sstr < 144) { const int q = gw / sstr; if (q < 128) conv_row(a, 8192 + q, lane); else conv_row(a, ((q - 128) >> 2) * 2048 + ((q - 128) & 3), lane); } }
        else for (int q = gw; q < 144; q += nw) { if (q < 128) conv_row(a, 8192 + q, lane); else conv_row(a, ((q - 128) >> 2) * 2048 + ((q - 128) & 3), lane); }
    }
}

__device__ __forceinline__ void phase_norm_ssm(CArgs& a) {
    const int wid = tid_() >> 6, lane = tid_() & 63; const int gw = blockIdx.x * 8 + wid, nw = gridDim.x * 8;
    const float* rowsq = (const float*)(a.ws + OFF_ROWSQ);
    for (int r = gw; r < MROWS; r += nw) {
        const float rr = rsqrtf(rowsq[r] * (1.0f / 1024.0f) + 1e-6f);
        bf16_t* MG = (bf16_t*)(a.ws + OFF_MERGED) + (size_t)r * 2048;
#pragma unroll
        for (int hh = 0; hh < 2; ++hh) { const int j = hh * 512 + lane * 8; float v[8]; unpack8(*(const u32x4*)(MG + j), v);
            const f32x4 ga = *(const f32x4*)(a.g_ssm + j), gb = *(const f32x4*)(a.g_ssm + j + 4);
            u32x4 w; w.x = pk(v[0] * rr * ga[0], v[1] * rr * ga[1]); w.y = pk(v[2] * rr * ga[2], v[3] * rr * ga[3]); w.z = pk(v[4] * rr * gb[0], v[5] * rr * gb[1]); w.w = pk(v[6] * rr * gb[2], v[7] * rr * gb[3]);
            *(u32x4*)(MG + j) = w; }
    }
}
__device__ __forceinline__ void load_preln_row(CArgs& a, const bf16_t* Z, int r, int lane, int S, f32x4 (&v)[8]) {
    if (r < 8192) { const bf16_t* src = Z + (size_t)r * D;
#pragma unroll
        for (int i = 0; i < 8; ++i) { const u32x2 x = __builtin_nontemporal_load((const u32x2*)(src + i * 256 + lane * 4)); v[i] = (f32x4){bflo(x.x), bfhi(x.x), bflo(x.y), bfhi(x.y)}; }
        return; }
    const bf16_t* X = (const bf16_t*)(a.ws + OFF_X) + (size_t)r * D; const float* SL = (const float*)(a.ws + OFF_SLAB) + (size_t)(r - 8192) * 2048;
#pragma unroll
    for (int i = 0; i < 8; ++i) { const u32x2 x = *(const u32x2*)(X + i * 256 + lane * 4); v[i] = (f32x4){ALPHA * bflo(x.x), ALPHA * bfhi(x.x), ALPHA * bflo(x.y), ALPHA * bfhi(x.y)}; }
#pragma unroll 4
    for (int s = 0; s < S; ++s) {
#pragma unroll
        for (int i = 0; i < 8; ++i) v[i] += *(const f32x4*)(SL + (size_t)s * 128 * 2048 + i * 256 + lane * 4); }
}
template <class F> __device__ __forceinline__ void ln_rows(int gw, int nw, F&& do_row) {
    if (nw % 128 != 0) { for (int r = gw; r < MROWS; r += nw) do_row(r); return; }
    const int tstr = nw / 128;
    if ((tstr & 1) || 8192 % nw != 0) { for (int r = gw; r < 8192; r += nw) do_row(r); if (gw % tstr == 0) do_row(8192 + gw / tstr); return; }
    const int last = 8192 - nw + gw;
    if (gw % tstr == 0) { for (int r = gw; r < last; r += nw) do_row(r); do_row(8192 + gw / tstr); }
    else { for (int r = gw; r < 8192; r += nw) do_row(r); if (gw % tstr == tstr / 2) do_row(last - tstr / 2); }
}
__device__ __forceinline__ void phase_ln1(CArgs& a, unsigned char* smem) {
    const int wid = tid_() >> 6, lane = tid_() & 63; const int gw = blockIdx.x * 8 + wid, nw = gridDim.x * 8;
    ln_rows(gw, nw, [&](int r) {
        bf16_t* X = (bf16_t*)(a.ws + OFF_X) + (size_t)r * D;
        f32x4 v[8]; load_preln_row(a, (const bf16_t*)(a.ws + OFF_Z1), r, lane, S_OUT, v);
        f32x4 gg[8], bb[8];
#pragma unroll
        for (int i = 0; i < 8; ++i) { gg[i] = *(const f32x4*)(a.ln1_g + i * 256 + lane * 4); bb[i] = *(const f32x4*)(a.ln1_b + i * 256 + lane * 4); }
        float mean, rstd; ln_row_stats(v, mean, rstd);
#pragma unroll
        for (int i = 0; i < 8; ++i) { const f32x4 y = (v[i] - mean) * rstd * gg[i] + bb[i];
            *(u32x2*)(X + i * 256 + lane * 4) = (u32x2){pk(y[0], y[1]), pk(y[2], y[3])}; }
    });
}
__device__ __forceinline__ void phase_ln2(CArgs& a) {
    const int wid = tid_() >> 6, lane = tid_() & 63; const int gw = blockIdx.x * 8 + wid, nw = gridDim.x * 8;
    ln_rows(gw, nw, [&](int r) {
        float* dst = a.out + (size_t)r * D;
        f32x4 v[8]; load_preln_row(a, (const bf16_t*)(a.ws + OFF_Z2), r, lane, S_DOWN, v);
        f32x4 gg[8], bb[8];
#pragma unroll
        for (int i = 0; i < 8; ++i) { gg[i] = *(const f32x4*)(a.ln2_g + i * 256 + lane * 4); bb[i] = *(const f32x4*)(a.ln2_b + i * 256 + lane * 4); }
        float mean, rstd; ln_row_stats(v, mean, rstd);
#pragma unroll
        for (int i = 0; i < 8; ++i) __builtin_nontemporal_store((v[i] - mean) * rstd * gg[i] + bb[i], (f32x4*)(dst + i * 256 + lane * 4));
    });
}
__device__ __forceinline__ void run_phase(CArgs& a, int ph, unsigned char* smem) {
    unsigned char* ws = a.ws;
    switch (ph) {
    case 0: phase_prep(a, smem); break;
    case 1: { EpiProj E; E.O = (bf16_t*)(ws + OFF_PROJ); E.ldc = DPROJ; E.slab = (float*)(ws + OFF_SLAB); E.ubuf = (bf16_t*)a.out; run_gemm_tail(smem, (const bf16_t*)(ws + OFF_X), (const bf16_t*)(ws + OFF_WIN), DPROJ, 2048, S_PROJ, E); } break;
    case 2: phase_mixers(a, smem); break;
    case 10: phase_tail_reduce(a); break;
    case 3: { EpiGlu E; E.Y = (const bf16_t*)(ws + OFF_YACT); E.O = (bf16_t*)(ws + OFF_MERGED); E.rowsq = (float*)(ws + OFF_ROWSQ); run_gemm(smem, (const bf16_t*)(ws + OFF_YACT), (const bf16_t*)(ws + OFF_WGLU), MPAD, 1024, 1024, E); side_transposes(a, smem, 0, 33 * 4, 264); } break;
    case 4: phase_norm_ssm(a); break;
    case 5: { EpiRes<true> E; E.rowsq = (const float*)(ws + OFF_ROWSQ); E.mid_t = 16; E.X = (const bf16_t*)(ws + OFF_X); E.Z = (bf16_t*)(ws + OFF_Z1); E.slab = (float*)(ws + OFF_SLAB); run_gemm_tail(smem, (const bf16_t*)(ws + OFF_MERGED), (const bf16_t*)(ws + OFF_WOUT), 2048, 2048, S_OUT, E); } break;
    case 6: phase_ln1(a, smem); break;
    case 7: { EpiGateUp E; E.O = (bf16_t*)(ws + OFF_HMID); run_gemm<EpiGateUp, true>(smem, (const bf16_t*)(ws + OFF_X), (const bf16_t*)(ws + OFF_WGU), MPAD, 11264, 2048, E); side_transposes(a, smem, 1, 33 * 44, 0); } break;
    case 8: { EpiRes<false> E; E.rowsq = nullptr; E.mid_t = -1; E.X = (const bf16_t*)(ws + OFF_X); E.Z = (bf16_t*)(ws + OFF_Z2); E.slab = (float*)(ws + OFF_SLAB); run_gemm_tail(smem, (const bf16_t*)(ws + OFF_HMID), (const bf16_t*)(ws + OFF_WDT), 2048, DFF, S_DOWN, E); } break;
    case 9: phase_ln2(a); break;
    }
}

#define XB_TMO      128
#define XB_XCNT(j)  (256  + 64 * (j))
#define XB_XSUB(j)  (1280 + 64 * (j))
#define XB_XGEN(j)  (2304 + 64 * (j))
#define XB_TOP      3328
#define XB_TOPGEN   3392
#define XCD_BAR_WORDS 3456
#define XB_SPIN_CAP (1u << 18)
#define LAS __attribute__((address_space(3)))

__device__ __forceinline__ unsigned xb_ld(unsigned* p)              { return __hip_atomic_load(p, __ATOMIC_RELAXED, __HIP_MEMORY_SCOPE_AGENT); }
__device__ __forceinline__ unsigned xb_add(unsigned* p, unsigned v) { return __hip_atomic_fetch_add(p, v, __ATOMIC_RELAXED, __HIP_MEMORY_SCOPE_AGENT); }
__device__ __forceinline__ unsigned xb_xcc_id() { return (unsigned)__builtin_amdgcn_s_getreg((3 << 11) | 20) & 0xFu; }
#define XB_SPIN(cond, bar) do { unsigned _sp = 0; while (cond) { __builtin_amdgcn_s_sleep(1); \
    if ((++_sp & 255u) == 0u) { if (xb_ld(&(bar)[XB_TMO])) break; if (_sp > XB_SPIN_CAP) { atomicAdd(&(bar)[XB_TMO], 1u); break; } } } } while (0)

struct XcdBarrier {
    unsigned* bar; unsigned x;
    volatile LAS unsigned* st;
};

__device__ __forceinline__ XcdBarrier xcd_barrier_post(unsigned* bar, volatile LAS unsigned* st) {
    XcdBarrier b; b.bar = bar; b.x = xb_xcc_id(); b.st = st;
    if (tid_() == 0) (void)xb_add(&bar[XB_XCNT(b.x)], 1u);
    return b;
}
__device__ __forceinline__ void xcd_barrier_complete(unsigned* bar, unsigned x, unsigned& nloc, unsigned& nx) {
    const unsigned G = gridDim.x * gridDim.y * gridDim.z;
    unsigned sum, cnt, mine, sp = 0u;
    for (;;) {
        sum = 0u; cnt = 0u; mine = 0u;
#pragma unroll
        for (unsigned j = 0; j < 16; ++j) { const unsigned c = xb_ld(&bar[XB_XCNT(j)]); sum += c; cnt += (c > 0u) ? 1u : 0u; mine = (j == x) ? c : mine; }
        if (sum == G) break;
        __builtin_amdgcn_s_sleep(1);
        if ((++sp & 255u) == 0u) { if (xb_ld(&bar[XB_TMO])) break; if (sp > XB_SPIN_CAP) { atomicAdd(&bar[XB_TMO], 1u); break; } }
    }
    nloc = mine > 0u ? mine : 1u; nx = cnt > 0u ? cnt : 1u;
}

__device__ __forceinline__ void xcd_barrier(const XcdBarrier& b) {
    asm volatile("s_waitcnt vmcnt(0)" ::: "memory");
    __syncthreads();
    if (tid_() == 0) {
        unsigned* bar = b.bar;
        __builtin_amdgcn_s_waitcnt(0);
        unsigned nloc = b.st[0], nx = b.st[1];
        if (nloc == 0u) { xcd_barrier_complete(bar, b.x, nloc, nx); b.st[0] = nloc; b.st[1] = nx; }
        const unsigned old = xb_add(&bar[XB_XSUB(b.x)], 1u);
        const unsigned gen = old / nloc;
        if (old + 1u == (gen + 1u) * nloc) {
            __builtin_amdgcn_fence(__ATOMIC_RELEASE, "agent");
            asm volatile("s_waitcnt vmcnt(0)" ::: "memory");
            const unsigned og = xb_add(&bar[XB_TOP], 1u);
            const unsigned tg = og / nx;
            if (og + 1u == (tg + 1u) * nx) xb_add(&bar[XB_TOPGEN], 1u);
            else XB_SPIN(xb_ld(&bar[XB_TOPGEN]) == tg, bar);
            __builtin_amdgcn_fence(__ATOMIC_ACQUIRE, "agent");
            xb_add(&bar[XB_XGEN(b.x)], 1u);
            asm volatile("s_waitcnt vmcnt(0)" ::: "memory");
        } else {
            XB_SPIN(xb_ld(&bar[XB_XGEN(b.x)]) == gen, bar);
            __builtin_amdgcn_fence(__ATOMIC_ACQUIRE, "agent");
            asm volatile("s_waitcnt vmcnt(0)" ::: "memory");
        }
    }
    __syncthreads();
}


#ifndef MULTI_LAUNCH
#define MULTI_LAUNCH 0
#endif
#if MULTI_LAUNCH
template <int PH> __global__ void __launch_bounds__(512, 2) k_ph(Args a) {
    extern __shared__ __attribute__((aligned(16))) unsigned char smem[];
    run_phase(a, PH, smem);
}
template <int PH> static void launch_ph(CArgs& a, int grid, hipStream_t stream) {
    static bool init = false;
    if (!init) { (void)hipFuncSetAttribute((const void*)k_ph<PH>, hipFuncAttributeMaxDynamicSharedMemorySize, LDS_BYTES); init = true; }
    hipLaunchKernelGGL(k_ph<PH>, dim3(grid), dim3(512), LDS_BYTES, stream, a);
}
#else
#define PHASE_ARGS() (*({ CArgs* p_ = (CArgs*)__builtin_amdgcn_kernarg_segment_ptr(); asm volatile("" : "+s"(p_)); p_; }))
__global__ void __launch_bounds__(512, 2) hymba_fwd(Args a_) {
    extern __shared__ __attribute__((aligned(16))) unsigned char smem[];
    cg::grid_group grid = cg::this_grid();
    volatile LAS unsigned* st = (volatile LAS unsigned*)(smem + 152064);
    if (tid_() == 0) { st[0] = 0u; st[1] = 0u; st[2] = 0u; st[3] = 0u; }
    __syncthreads();
    const XcdBarrier bar = xcd_barrier_post((unsigned*)(PHASE_ARGS().ws + OFF_BAR), st);
    if (PHASE_ARGS().never) grid.sync();
    run_phase(PHASE_ARGS(), 0, smem); xcd_barrier(bar);
    run_phase(PHASE_ARGS(), 1, smem); xcd_barrier(bar);
    run_phase(PHASE_ARGS(), 10, smem); xcd_barrier(bar);
    run_phase(PHASE_ARGS(), 2, smem); xcd_barrier(bar);
    run_phase(PHASE_ARGS(), 3, smem); xcd_barrier(bar);
    run_phase(PHASE_ARGS(), 5, smem); xcd_barrier(bar);
    run_phase(PHASE_ARGS(), 6, smem); xcd_barrier(bar);
    run_phase(PHASE_ARGS(), 7, smem); xcd_barrier(bar);
    run_phase(PHASE_ARGS(), 8, smem); xcd_barrier(bar);
    run_phase(PHASE_ARGS(), 9, smem);
}
#endif
extern "C" void kernel_launch(void* const* d_in, const int* in_sizes, int n_in, void* d_out, int out_size, void* d_ws, size_t ws_size, hipStream_t stream) {
    static int grid_blocks = 0;
    if (!grid_blocks) {
        int dev = 0, cus = 0;
        (void)hipGetDevice(&dev);
        (void)hipDeviceGetAttribute(&cus, hipDeviceAttributeMultiprocessorCount, dev);
#if !MULTI_LAUNCH
        int per_cu = 0;
        (void)hipFuncSetAttribute((const void*)hymba_fwd, hipFuncAttributeMaxDynamicSharedMemorySize, LDS_BYTES);
        (void)hipOccupancyMaxActiveBlocksPerMultiprocessor(&per_cu, (const void*)hymba_fwd, 512, LDS_BYTES);
        if (per_cu < 1) fprintf(stderr, "occupancy query returned %d workgroups per CU\n", per_cu);
#endif
        grid_blocks = cus;
        if (ws_size < WS_END) fprintf(stderr, "workspace too small: %zu < %zu\n", ws_size, (size_t)WS_END);
    }
    Args a{};
    const float** pp = (const float**)&a;
    for (int i = 0; i < 29; ++i) pp[i] = (const float*)d_in[i];
    a.out = (float*)d_out; a.ws = (unsigned char*)d_ws;
#if MULTI_LAUNCH
    launch_ph<0>(a, grid_blocks, stream); launch_ph<1>(a, grid_blocks, stream); launch_ph<2>(a, grid_blocks, stream); launch_ph<3>(a, grid_blocks, stream); launch_ph<4>(a, grid_blocks, stream);
    launch_ph<5>(a, grid_blocks, stream); launch_ph<6>(a, grid_blocks, stream); launch_ph<7>(a, grid_blocks, stream); launch_ph<8>(a, grid_blocks, stream); launch_ph<9>(a, grid_blocks, stream);
#else
    (void)hipMemsetAsync((char*)d_ws + OFF_BAR, 0, BAR_BYTES, stream);
    void* args[] = {&a};
    hipError_t e = hipLaunchCooperativeKernel((const void*)hymba_fwd, dim3(grid_blocks), dim3(512), args, LDS_BYTES, stream);
    if (e != hipSuccess) fprintf(stderr, "cooperative launch failed: %s (grid %d)\n", hipGetErrorString(e), grid_blocks);
#endif
}
```

```cpp
#include <hip/hip_runtime.h>
#include <hip/hip_cooperative_groups.h>
#include <cstdio>
#include <cstdint>
namespace cg = cooperative_groups;
__device__ __forceinline__ int tid_() { int t = (int)threadIdx.x; asm volatile("" : "+v"(t)); return t; }
namespace pg8 {
#define PG8_LAS __attribute__((address_space(3)))
typedef unsigned short bf16_t;
typedef short bf16x8 __attribute__((ext_vector_type(8)));
typedef float f32x4 __attribute__((ext_vector_type(4)));
typedef unsigned u32x4 __attribute__((ext_vector_type(4)));
constexpr int BM = 256, BK = 64, HALF = 128, HTB = HALF * BK * 2  , STAGE_BYTES = 8 * HTB, NXCD = 8, WGM = 4;

__host__ __device__ __forceinline__ int lds_byte(int r, int c) { const int st = (r >> 4) * 2 + (c >> 5), rr = r & 15, cc = c & 31, ob = rr * 64 + cc * 2; return st * 1024 + (ob ^ (((ob >> 9) & 1) << 5)); }
__host__ __device__ __forceinline__ void stage_rc(int b, int& R, int& C) { const int st = b / 1024, sb = b % 1024, swz = sb ^ (((sb >> 9) & 1) << 5); R = (st >> 1) * 16 + swz / 64; C = (st & 1) * 32 + (swz % 64) / 2; }
__host__ __device__ __forceinline__ int perm32(int rho) { const int n = rho >> 4, i = rho & 15; return 8 * (i >> 2) + 4 * n + (i & 3); }

struct Unit { int pm, pn, kt0, nkt, tail; };
struct Gemm { const bf16_t* A; const bf16_t* Bt; int M, N, K; };

struct StaticOrder {
    int nM, nN, nwg, G, c, ktiles;
    __host__ __device__ void init(int M, int N, int G_, int c_) { nM = M / BM; nN = N / BM; nwg = nM * nN; G = G_; c = c_; }
    __host__ __device__ bool next(int i, Unit& u) const {
        const long L = (long)i * G + c; if (L >= nwg) return false;
        int wgid = (int)L; { const int q = nwg / NXCD, r = nwg % NXCD, xcd = wgid % NXCD, off = wgid / NXCD; wgid = (xcd < r ? xcd * (q + 1) : r * (q + 1) + (xcd - r) * q) + off; }
        const int nig = WGM * nN, gid = wgid / nig, fm = gid * WGM, gsz = (nM - fm) < WGM ? (nM - fm) : WGM;
        u.pm = fm + ((wgid % nig) % gsz); u.pn = (wgid % nig) / gsz; u.kt0 = 0; u.nkt = ktiles; u.tail = 0; return true;
    }
    __device__ __forceinline__ void a_ready(const Unit&) const {}
    __device__ __forceinline__ void done(const Unit&) const {}
};
__device__ __forceinline__ unsigned cvt_pk_bf16(float lo, float hi) { unsigned r; asm volatile("v_cvt_pk_bf16_f32 %0, %1, %2" : "=v"(r) : "v"(lo), "v"(hi)); return r; }
template <class Epi, class Sched, bool STAMP = false, bool SP2 = true, bool ALIGN_EPI = false>
__device__ __forceinline__ void gemm_phase(PG8_LAS unsigned char* lds, const Gemm g, const Sched& S, const Epi& E, unsigned long long* stamps) {
    const int tid = tid_(), wid = __builtin_amdgcn_readfirstlane(tid >> 6), lane = tid & 63, wr = wid >> 2, wc = wid & 3, fr = lane & 15, fq = lane >> 4;
    const int K = g.K;
    int ts_lo = 0, ts_hi = 0, nts = 0; const unsigned long long rt_entry = STAMP ? (unsigned long long)wall_clock64() : 0ull;
#define PG8_STAMP() do { if (STAMP && wid == 0 && nts < 64) { const unsigned long long _c = (unsigned long long)clock64(); \
        ts_lo = (lane == nts) ? (int)(unsigned)_c : ts_lo; ts_hi = (lane == nts) ? (int)(unsigned)(_c >> 32) : ts_hi; ++nts; } } while (0)
    PG8_STAMP();
    unsigned voffA[2], voffB[2];
#pragma unroll
    for (int i = 0; i < 2; ++i) { int R, C; stage_rc(tid * 16 + i * 8192, R, C); const int Rb = Epi::PERM ? ((R & ~31) + perm32(R & 31)) : R;
        voffA[i] = (unsigned)(R * K + C) * 2u; voffB[i] = (unsigned)(Rb * K + C) * 2u; }
    const size_t kstep = (size_t)(BK * 2);
    const size_t hstep = (size_t)HALF * K * 2;
    const size_t tstep = 2 * hstep;
    const unsigned ldsw = (unsigned)wid * 1024u;
    const int aoff = lds_byte(wr * 64 + fr, fq * 8), boff = lds_byte(wc * 32 + fr, fq * 8);
#define PG8_SA(b, h) (((b) * 2 + (h)) * HTB)
#define PG8_SB(b, h) ((4 + (b) * 2 + (h)) * HTB)
#define PG8_STAGE(bufoff, gbase, voff) do { _Pragma("unroll") for (int _i = 0; _i < 2; ++_i) \
        __builtin_amdgcn_global_load_lds((const unsigned*)((const char*)(gbase) + (voff)[_i]), (PG8_LAS unsigned*)(lds + (bufoff) + ldsw + _i * 8192), 16, 0, 0); } while (0)
#define PG8_LDA(dst, b, h) do { _Pragma("unroll") for (int m = 0; m < 4; ++m) _Pragma("unroll") for (int k = 0; k < 2; ++k) dst[m][k] = *(const PG8_LAS bf16x8*)(lds + PG8_SA(b, h) + aoff + m * 2048 + k * 1024); } while (0)
#define PG8_LDB(dst, b, h) do { _Pragma("unroll") for (int n = 0; n < 2; ++n) _Pragma("unroll") for (int k = 0; k < 2; ++k) dst[n][k] = *(const PG8_LAS bf16x8*)(lds + PG8_SB(b, h) + boff + n * 2048 + k * 1024); } while (0)
#define PG8_MMA(ai, bj, At, Bt) do { __builtin_amdgcn_s_setprio(1); _Pragma("unroll") for (int m = 0; m < 4; ++m) _Pragma("unroll") for (int n = 0; n < 2; ++n) _Pragma("unroll") for (int k = 0; k < 2; ++k) \
        acc[ai][bj][m][n] = __builtin_amdgcn_mfma_f32_16x16x32_bf16(Bt[n][k], At[m][k], acc[ai][bj][m][n], 0, 0, 0); __builtin_amdgcn_s_setprio(0); } while (0)
#define PG8_WAIT_V(n) asm volatile("s_waitcnt vmcnt(" #n ")" ::: "memory")
#define PG8_WAIT_L(n) asm volatile("s_waitcnt lgkmcnt(" #n ")" ::: "memory")
#define PG8_BAR __builtin_amdgcn_s_barrier()
#define PG8_SCHED __builtin_amdgcn_sched_barrier(0)
    Unit cur, nxt; int ui = 0;
    if (!S.next(0, cur)) return;
    f32x4 acc[2][2][4][2];
#pragma unroll
    for (int a = 0; a < 2; ++a)
#pragma unroll
        for (int b = 0; b < 2; ++b)
#pragma unroll
            for (int m = 0; m < 4; ++m)
#pragma unroll
                for (int n = 0; n < 2; ++n) acc[a][b][m][n] = (f32x4){0.f, 0.f, 0.f, 0.f};
    bf16x8 At[4][2], B0[2][2], B1[2][2];
    const char* cA = (const char*)g.A + (size_t)cur.pm * tstep + (size_t)cur.kt0 * kstep; const char* cB = (const char*)g.Bt + (size_t)cur.pn * tstep + (size_t)cur.kt0 * kstep;
    S.a_ready(cur);
    if constexpr (SP2) {
        PG8_STAGE(PG8_SB(0, 0), cB, voffB); PG8_STAGE(PG8_SB(0, 1), cB + hstep, voffB); PG8_STAGE(PG8_SA(0, 0), cA, voffA); PG8_STAGE(PG8_SA(0, 1), cA + hstep, voffA);
        if (wr == 1) PG8_BAR;
        PG8_WAIT_V(2); PG8_BAR;
        PG8_STAGE(PG8_SB(1, 0), cB + kstep, voffB); PG8_STAGE(PG8_SA(1, 0), cA + kstep, voffA); PG8_STAGE(PG8_SB(1, 1), cB + hstep + kstep, voffB);
        PG8_WAIT_V(6); PG8_BAR;
    } else {
    PG8_STAGE(PG8_SB(0, 0), cB, voffB); PG8_STAGE(PG8_SA(0, 0), cA, voffA); PG8_STAGE(PG8_SB(0, 1), cB + hstep, voffB); PG8_STAGE(PG8_SA(0, 1), cA + hstep, voffA);
    if (wr == 1) PG8_BAR;
    PG8_WAIT_V(4); PG8_BAR;
    PG8_STAGE(PG8_SB(1, 0), cB + kstep, voffB); PG8_STAGE(PG8_SA(1, 0), cA + kstep, voffA); PG8_STAGE(PG8_SB(1, 1), cB + hstep + kstep, voffB);
    PG8_WAIT_V(6); PG8_BAR;
    }
    PG8_STAMP();
    for (;;) {
        const bool has_next = S.next(ui + 1, nxt);
        const char* nA = has_next ? (const char*)g.A + (size_t)nxt.pm * tstep + (size_t)nxt.kt0 * kstep : cA; const char* nB = has_next ? (const char*)g.Bt + (size_t)nxt.pn * tstep + (size_t)nxt.kt0 * kstep : cB;
        const int nt = cur.nkt;
        for (int t = 0; t < nt; t += 2) {
            const bool last = (t == nt - 2);
            if constexpr (Epi::HAS_MID) { if (t == E.mid_t && !cur.tail) E.mid(acc, cur, wr, fr); }
            const char* a1 = cA + (size_t)(t + 1) * kstep;
            const char* a2 = last ? nA : cA + (size_t)(t + 2) * kstep; const char* b2 = last ? nB : cB + (size_t)(t + 2) * kstep;
            const char* a3 = a2 + kstep; const char* b3 = b2 + kstep;
            if (last && has_next) S.a_ready(nxt);
            if constexpr (SP2) {
            PG8_LDB(B0, 0, 0); PG8_LDB(B1, 0, 1); PG8_SCHED; PG8_LDA(At, 0, 0); PG8_STAGE(PG8_SA(1, 1), a1 + hstep, voffA);
            PG8_WAIT_V(8); PG8_WAIT_L(0); PG8_BAR; PG8_MMA(0, 0, At, B0); PG8_MMA(0, 1, At, B1); PG8_BAR; PG8_SCHED;
            PG8_LDA(At, 0, 1); PG8_STAGE(PG8_SB(0, 0), b2, voffB); PG8_STAGE(PG8_SB(0, 1), b2 + hstep, voffB); PG8_STAGE(PG8_SA(0, 0), a2, voffA);
            PG8_WAIT_V(8); PG8_WAIT_L(0); PG8_BAR; PG8_MMA(1, 0, At, B0); PG8_MMA(1, 1, At, B1); PG8_BAR; PG8_SCHED;
            PG8_LDB(B0, 1, 0); PG8_LDB(B1, 1, 1); PG8_SCHED; PG8_LDA(At, 1, 0); PG8_STAGE(PG8_SA(0, 1), a2 + hstep, voffA);
            PG8_WAIT_V(8); PG8_WAIT_L(0); PG8_BAR; PG8_MMA(0, 0, At, B0); PG8_MMA(0, 1, At, B1); PG8_BAR; PG8_SCHED;
            PG8_LDA(At, 1, 1); PG8_STAGE(PG8_SB(1, 0), b3, voffB); PG8_STAGE(PG8_SB(1, 1), b3 + hstep, voffB); PG8_STAGE(PG8_SA(1, 0), a3, voffA);
            PG8_WAIT_V(8); PG8_WAIT_L(0); PG8_BAR; PG8_MMA(1, 0, At, B0); PG8_MMA(1, 1, At, B1); PG8_BAR; PG8_SCHED;
            } else {
            PG8_LDB(B0, 0, 0); PG8_SCHED; PG8_LDA(At, 0, 0); PG8_STAGE(PG8_SA(1, 1), a1 + hstep, voffA);
            PG8_WAIT_L(8); PG8_BAR; PG8_WAIT_L(0); PG8_MMA(0, 0, At, B0); PG8_BAR; PG8_SCHED;
            PG8_LDB(B1, 0, 1); PG8_STAGE(PG8_SB(0, 0), b2, voffB);
            PG8_BAR; PG8_WAIT_L(0); PG8_MMA(0, 1, At, B1); PG8_BAR;
            PG8_LDA(At, 0, 1); PG8_STAGE(PG8_SA(0, 0), a2, voffA);
            PG8_BAR; PG8_WAIT_L(0); PG8_MMA(1, 0, At, B0); PG8_BAR; PG8_SCHED;
            PG8_STAGE(PG8_SB(0, 1), b2 + hstep, voffB);
            PG8_WAIT_V(6); PG8_BAR; PG8_MMA(1, 1, At, B1); PG8_BAR;
            PG8_LDB(B0, 1, 0); PG8_SCHED; PG8_LDA(At, 1, 0); PG8_STAGE(PG8_SA(0, 1), a2 + hstep, voffA);
            PG8_WAIT_L(8); PG8_BAR; PG8_WAIT_L(0); PG8_MMA(0, 0, At, B0); PG8_BAR; PG8_SCHED;
            PG8_LDB(B1, 1, 1); PG8_STAGE(PG8_SB(1, 0), b3, voffB);
            PG8_BAR; PG8_WAIT_L(0); PG8_MMA(0, 1, At, B1); PG8_BAR;
            PG8_LDA(At, 1, 1); PG8_STAGE(PG8_SA(1, 0), a3, voffA);
            PG8_BAR; PG8_WAIT_L(0); PG8_MMA(1, 0, At, B0); PG8_BAR; PG8_SCHED;
            PG8_STAGE(PG8_SB(1, 1), b3 + hstep, voffB);
            PG8_WAIT_V(6); PG8_BAR; PG8_MMA(1, 1, At, B1); PG8_BAR;
            }
        }
        PG8_STAMP();
        if constexpr (ALIGN_EPI) { if (wr == 0) PG8_BAR; }
        if constexpr (!Epi::AFTER_DRAIN) { E(acc, cur, wr, wc, fr, fq); S.done(cur); }
        PG8_STAMP();
        if (!has_next) break;
#pragma unroll
        for (int a = 0; a < 2; ++a)
#pragma unroll
            for (int b = 0; b < 2; ++b)
#pragma unroll
                for (int m = 0; m < 4; ++m)
#pragma unroll
                    for (int n = 0; n < 2; ++n) acc[a][b][m][n] = (f32x4){0.f, 0.f, 0.f, 0.f};
        cur = nxt; cA = nA; cB = nB; ++ui;
        if constexpr (ALIGN_EPI) { if (wr == 1) PG8_BAR; }
    }
    PG8_WAIT_V(0);
    if constexpr (!ALIGN_EPI) { if (wr == 0) PG8_BAR; }
    PG8_BAR;
    if constexpr (Epi::AFTER_DRAIN) { E.fused(acc, cur, wr, wc, fr, fq, lds, wid, lane); S.done(cur); }
    PG8_STAMP();
    if (STAMP && wid == 0) { stamps[lane] = lane < nts ? (((unsigned long long)(unsigned)ts_hi << 32) | (unsigned)ts_lo) : 0ull;
        if (lane == 62) stamps[62] = rt_entry; if (lane == 63) stamps[63] = (unsigned long long)wall_clock64(); }
#undef PG8_STAMP
#undef PG8_SA
#undef PG8_SB
#undef PG8_STAGE
#undef PG8_LDA
#undef PG8_LDB
#undef PG8_MMA
#undef PG8_WAIT_V
#undef PG8_WAIT_L
#undef PG8_BAR
#undef PG8_SCHED
}
}

#include <cstdio>
#include <ctime>
#include <cstdlib>
#include <cstring>
#include <cmath>
#include <vector>
#include <algorithm>
#define CK(x) do { hipError_t e_ = (x); if (e_ != hipSuccess) { fprintf(stderr, "HIP %s:%d %s\n", __FILE__, __LINE__, hipGetErrorString(e_)); exit(2); } } while (0)
using pg8::bf16_t; using pg8::bf16x8; using pg8::f32x4; using pg8::u32x4;
typedef unsigned u32x2 __attribute__((ext_vector_type(2)));

constexpr int D = 2048, DSSM = 1024, DPROJ = 4096, DFF = 5632;
constexpr int MROWS = 8320;
constexpr int MA = 8336;
constexpr int MPAD = 8448;
constexpr int META0 = 8320;
constexpr float ALPHA = 1.189207115002721f;
constexpr int S_PROJ = 8, S_OUT = 8, S_DOWN = 11;
constexpr int LDS_BYTES = 155648;

constexpr size_t OFF_WGU = 0;
constexpr size_t OFF_X = OFF_WGU + (size_t)11264 * 2048 * 2;
constexpr size_t OFF_D = OFF_X + (size_t)MPAD * 2048 * 2;
constexpr size_t OFF_HMID = OFF_D;
constexpr size_t OFF_WDT = OFF_HMID + (size_t)MPAD * DFF * 2;
constexpr size_t OFF_PROJ = OFF_D;
constexpr size_t OFF_YACT = OFF_PROJ + (size_t)MPAD * DPROJ * 2;
constexpr size_t OFF_MERGED = OFF_YACT + (size_t)MPAD * 1024 * 2;
constexpr size_t OFF_Z1 = OFF_PROJ;
constexpr size_t OFF_Z2 = OFF_WGU;
constexpr size_t OFF_WIN = OFF_MERGED + (size_t)MPAD * 2048 * 2;
constexpr size_t OFF_WGLU = OFF_WIN + (size_t)4096 * 2048 * 2;
constexpr size_t OFF_WOUT = OFF_WGLU + (size_t)1024 * 1024 * 2;
constexpr size_t OFF_SSMME = OFF_WOUT + (size_t)2048 * 2048 * 2;
constexpr size_t OFF_SSMF = OFF_SSMME + (size_t)64 * 256 * 384 * 2;
constexpr size_t OFF_SSMC = OFF_SSMF + (size_t)64 * 128 * 256 * 2;
constexpr size_t OFF_ROWSQ = OFF_SSMC + (size_t)64 * 2304 * 4;
constexpr size_t OFF_BAR = OFF_ROWSQ + (size_t)MPAD * 4;
constexpr size_t BAR_BYTES = 16384;
constexpr size_t OFF_SLAB = OFF_BAR + BAR_BYTES;
constexpr size_t WS_END = OFF_SLAB + (size_t)8 * 144 * 4096 * 4;
static_assert(OFF_WDT + (size_t)2048 * DFF * 2 <= WS_END, "wdt inside region D");
static_assert(WS_END <= (size_t)256 * 1024 * 1024, "workspace");

constexpr size_t O_YP = 0, O_YS = 16777216, O_PRE = 17039360, O_PIM = 17055744, O_PCV = 17072128, O_SRE = 17080320, O_SIM = 17604608, O_SCV = 18128896;

struct Args {
    const float *x_prompt, *x_sample, *st_re, *st_im, *st_conv, *meta, *ln0_g, *ln0_b, *w_in, *a_re, *a_im, *log_dt, *b_re, *b_im, *c_re, *c_im, *ssm_d, *w_glu, *conv_w, *g_ssm, *g_conv,
        *w_out, *ln1_g, *ln1_b, *w_gate, *w_up, *w_down, *ln2_g, *ln2_b;
    float* out; unsigned char* ws;
    int never; int pad_;
};

typedef const __attribute__((address_space(4))) Args CArgs;
__device__ __forceinline__ float bf2f(unsigned short b) { return __uint_as_float(((unsigned)b) << 16); }
__device__ __forceinline__ float bflo(unsigned w) { return __uint_as_float(w << 16); }
__device__ __forceinline__ float bfhi(unsigned w) { return __uint_as_float(w & 0xffff0000u); }
__device__ __forceinline__ unsigned pk(float lo, float hi) { return pg8::cvt_pk_bf16(lo, hi); }
__device__ __forceinline__ float wave_sum(float v) {
#pragma unroll
    for (int o = 32; o > 0; o >>= 1) v += __shfl_xor(v, o);
    return v;
}
__device__ __forceinline__ float sigmoidf_(float z) { return __builtin_amdgcn_rcpf(1.0f + __expf(-z)); }
__device__ __forceinline__ float gelu_tanh(float x) { const float z = 1.5957691216057308f * (x + 0.044715f * x * x * x); return x * sigmoidf_(z); }

struct RowMap { int mode;
    __device__ __forceinline__ int operator()(int n) const { return mode == 0 ? n : ((n >> 7) << 8) + (n & 127) + (mode == 2 ? 128 : 0); } };
struct TileDesc { const float* src; int ld, k0, n0; bf16_t* dst; int ldd; RowMap rm; const float* kscale; };
__device__ __forceinline__ void tile_load(const TileDesc& d, f32x4 (&v)[8]) {
    const int tid = tid_(), row = tid >> 6, c4 = (tid & 63) * 4;
#pragma unroll
    for (int i = 0; i < 8; ++i) v[i] = __builtin_nontemporal_load((const f32x4*)(d.src + (size_t)(d.k0 + row + 8 * i) * d.ld + d.n0 + c4));
}
__device__ __forceinline__ void tile_lds(const TileDesc& d, f32x4 (&v)[8], float* T) {
    const int tid = tid_(), row = tid >> 6, c4 = (tid & 63) * 4;
    if (d.kscale) {
#pragma unroll
        for (int i = 0; i < 8; ++i) v[i] *= d.kscale[d.k0 + row + 8 * i]; }
#pragma unroll
    for (int i = 0; i < 8; ++i) *(f32x4*)(T + (row + 8 * i) * 256 + (c4 ^ (i << 3))) = v[i];
}
__device__ __forceinline__ void tile_out(const TileDesc& d, const float* T) {
    const int tid = tid_(), kq = tid & 7, kc = kq * 8;
#pragma unroll
    for (int i = 0; i < 4; ++i) { const int n = (tid >> 3) + 64 * i; const float* t = T + kc * 256 + (n ^ (kq << 3));
        u32x4 w; w.x = pk(t[0], t[256]); w.y = pk(t[512], t[768]); w.z = pk(t[1024], t[1280]); w.w = pk(t[1536], t[1792]);
        __builtin_nontemporal_store(w, (u32x4*)(d.dst + (size_t)d.rm(d.n0 + n) * d.ldd + d.k0 + kc)); }
}
__device__ __forceinline__ void tile_store(const TileDesc& d, f32x4 (&v)[8], float* T) { tile_lds(d, v, T); __syncthreads(); tile_out(d, T); __syncthreads(); }
__device__ __forceinline__ void transpose_tile(const float* __restrict__ src, int ld, int k0, int n0, bf16_t* __restrict__ dst, int ldd, RowMap drow, float* T, const float* kscale = nullptr) {
    TileDesc d; d.src = src; d.ld = ld; d.k0 = k0; d.n0 = n0; d.dst = dst; d.ldd = ldd; d.rm = drow; d.kscale = kscale;
    f32x4 v[8]; tile_load(d, v); tile_store(d, v, T);
}

__device__ __forceinline__ void ln_row_stats(const f32x4 (&v)[8], float& mean, float& rstd) {
    float s = 0.f;
#pragma unroll
    for (int i = 0; i < 8; ++i) s += v[i][0] + v[i][1] + v[i][2] + v[i][3];
    mean = wave_sum(s) * (1.0f / 2048.0f);
    float q = 0.f;
#pragma unroll
    for (int i = 0; i < 8; ++i) {
#pragma unroll
        for (int j = 0; j < 4; ++j) { const float d = v[i][j] - mean; q += d * d; } }
    rstd = rsqrtf(wave_sum(q) * (1.0f / 2048.0f) + 1e-5f);
}

__device__ __forceinline__ void ssm_precompute(CArgs& a, int g, int qtr, unsigned char* smem) {
    float* Apr = (float*)smem;
    float* Api = Apr + 17 * 64;
    float* Bbr = Api + 17 * 64;
    float* Bbi = Bbr + 1024;
    float* Cr = Bbi + 1024;
    float* Ci = Cr + 1024;
    float* Km = Ci + 1024;
    float* Fr = Km + 4096;
    float* Fi = Fr + 64;
    float* Crt = Fi + 64;
    float* Cit = Crt + 1024;
    const int tid = tid_();
    float cr_[2], ci_[2], br_[2], bi_[2];
#pragma unroll
    for (int k = 0; k < 2; ++k) { const int i = tid + k * 512; cr_[k] = a.c_re[g * 1024 + i]; ci_[k] = a.c_im[g * 1024 + i]; br_[k] = a.b_re[g * 1024 + i]; bi_[k] = a.b_im[g * 1024 + i]; }
    const float twopi = 6.283185307179586f, inv2pi = 0.15915494309189535f;
    const float dt = expf(a.log_dt[g]);
    for (int i = tid; i < 17 * 64 + 64; i += 512) {
        const int p = i & 63, d = i >> 6;
        const float are = a.a_re[g * 64 + p], aim = a.a_im[g * 64 + p];
        if (d <= 16) {
            const float mag = expf((float)d * dt * are);
            float ang = (float)d * dt * aim;
            ang = fmaf(-twopi, rintf(ang * inv2pi), ang);
            const float sn = sinf(ang), cs = cosf(ang);
            Apr[d * 64 + p] = mag * cs;
            Api[d * 64 + p] = mag * sn;
        } else {
            const float mag = expf(dt * are); float ang = dt * aim; ang = fmaf(-twopi, rintf(ang * inv2pi), ang);
            const float sn = sinf(ang), c = cosf(ang);
            const float h = sinf(0.5f * ang);
            const float nre = expm1f(dt * are) * c - 2.f * h * h, nim = mag * sn;
            const float den = are * are + aim * aim;
            Fr[p] = (nre * are + nim * aim) / den;
            Fi[p] = (nim * are - nre * aim) / den;
        }
    }
#pragma unroll
    for (int k = 0; k < 2; ++k) { const int i = tid + k * 512; Cr[i] = cr_[k]; Ci[i] = ci_[k]; Crt[(i & 63) * 16 + (i >> 6)] = cr_[k]; Cit[(i & 63) * 16 + (i >> 6)] = ci_[k]; }
    __syncthreads();
#pragma unroll
    for (int k = 0; k < 2; ++k) { const int i = tid + k * 512, p = i >> 4; const float fr = Fr[p], fi = Fi[p];
        Bbr[i] = fr * br_[k] - fi * bi_[k]; Bbi[i] = fr * bi_[k] + fi * br_[k]; }
    __syncthreads();
    {
        const int d = tid >> 5, c = (tid >> 1) & 15, cb = (tid & 1) * 8;
        float acc[8];
#pragma unroll
        for (int j = 0; j < 8; ++j) acc[j] = 0.f;
        for (int p = 0; p < 64; ++p) {
            const float cr = Crt[p * 16 + c], ci = Cit[p * 16 + c], ar = Apr[d * 64 + p], ai = Api[d * 64 + p];
            const float xr = cr * ar - ci * ai, xi = cr * ai + ci * ar;
            const f32x4 b0 = *(const f32x4*)(Bbr + p * 16 + cb), b1 = *(const f32x4*)(Bbr + p * 16 + cb + 4), e0 = *(const f32x4*)(Bbi + p * 16 + cb), e1 = *(const f32x4*)(Bbi + p * 16 + cb + 4);
#pragma unroll
            for (int j = 0; j < 4; ++j) { acc[j] += xr * b0[j] - xi * e0[j]; acc[4 + j] += xr * b1[j] - xi * e1[j]; }
        }
#pragma unroll
        for (int j = 0; j < 8; ++j) Km[(d * 16 + c) * 16 + cb + j] = acc[j];
    }
    __syncthreads();
    bf16_t* ME = (bf16_t*)(a.ws + OFF_SSMME) + (size_t)g * 256 * 384;
    for (int ch = qtr * 64 * 48 + tid; ch < (qtr + 1) * 64 * 48; ch += 512) {
        const int row = ch / 48, kc = (ch % 48) * 8, t = row >> 4, c = row & 15;
        float v[8];
        if (kc < 256) { const int j = kc >> 4, c0 = kc & 15;
#pragma unroll
            for (int e = 0; e < 8; ++e) v[e] = (j <= t) ? Km[((t - j) * 16 + c) * 16 + c0 + e] : 0.f;
        } else { const bool im = kc >= 320; const int p0 = kc - (im ? 320 : 256);
#pragma unroll
            for (int e = 0; e < 8; ++e) { const int p = p0 + e; const float cr = Cr[c * 64 + p], ci = Ci[c * 64 + p], ar = Apr[(t + 1) * 64 + p], ai = Api[(t + 1) * 64 + p];
                v[e] = im ? -(cr * ai + ci * ar) : (cr * ar - ci * ai); } }
        u32x4 w; w.x = pk(v[0], v[1]); w.y = pk(v[2], v[3]); w.z = pk(v[4], v[5]); w.w = pk(v[6], v[7]);
        *(u32x4*)(ME + (size_t)row * 384 + kc) = w;
    }
    bf16_t* FT = (bf16_t*)(a.ws + OFF_SSMF) + (size_t)g * 128 * 256;
    for (int ch = qtr * 32 * 32 + tid; ch < (qtr + 1) * 32 * 32; ch += 512) {
        const int row = ch >> 5, kc = (ch & 31) * 8, im = row >> 6, p = row & 63, j = kc >> 4, c0 = kc & 15;
        const float ar = Apr[(15 - j) * 64 + p], ai = Api[(15 - j) * 64 + p];
        float v[8];
#pragma unroll
        for (int e = 0; e < 8; ++e) { const float br = Bbr[p * 16 + c0 + e], bi = Bbi[p * 16 + c0 + e]; v[e] = im ? (ar * bi + ai * br) : (ar * br - ai * bi); }
        u32x4 w; w.x = pk(v[0], v[1]); w.y = pk(v[2], v[3]); w.z = pk(v[4], v[5]); w.w = pk(v[6], v[7]);
        *(u32x4*)(FT + (size_t)row * 256 + kc) = w;
    }
    float* SC = (float*)(a.ws + OFF_SSMC) + (size_t)g * 2304;
    if (qtr == 0 && tid < 64) { SC[tid] = Apr[64 + tid]; SC[64 + tid] = Api[64 + tid]; SC[128 + tid] = Apr[16 * 64 + tid]; SC[192 + tid] = Api[16 * 64 + tid]; }
    if (qtr == 0) for (int i = tid; i < 1024; i += 512) { SC[256 + i] = Bbr[i]; SC[1280 + i] = Bbi[i]; }
    __syncthreads();
}

__device__ __forceinline__ void ln0_rows(CArgs& a, int rg, int wid, int lane, const f32x4 (&gg)[8], const f32x4 (&bb)[8]) {
    const int r = rg * 8 + wid;
    bf16_t* X = (bf16_t*)(a.ws + OFF_X) + (size_t)r * D;
    if (r >= MA) {
#pragma unroll
        for (int i = 0; i < 8; ++i) *(u32x2*)(X + i * 256 + lane * 4) = (u32x2){0u, 0u};
        return; }
    const float* src = r < 8192 ? a.x_prompt + (size_t)r * D : (r < META0 ? a.x_sample + (size_t)(r - 8192) * D : a.meta + (size_t)(r - META0) * D);
    f32x4 v[8];
#pragma unroll
    for (int i = 0; i < 8; ++i) v[i] = __builtin_nontemporal_load((const f32x4*)(src + i * 256 + lane * 4));
    float mean, rstd; ln_row_stats(v, mean, rstd);
#pragma unroll
    for (int i = 0; i < 8; ++i) { const f32x4 y = (v[i] - mean) * rstd * gg[i] + bb[i];
        *(u32x2*)(X + i * 256 + lane * 4) = (u32x2){pk(y[0], y[1]), pk(y[2], y[3])}; }
}

__device__ __forceinline__ void phase_prep(CArgs& a, unsigned char* smem, int mask = 7) {
    const int tid = tid_(), wid = tid >> 6, lane = tid & 63;
    { const int gi = blockIdx.x * 512 + tid; if (gi < MPAD) ((float*)(a.ws + OFF_ROWSQ))[gi] = 0.f; }
    f32x4 gg[8], bb[8];
#pragma unroll
    for (int i = 0; i < 8; ++i) { gg[i] = *(const f32x4*)(a.ln0_g + i * 256 + lane * 4); bb[i] = *(const f32x4*)(a.ln0_b + i * 256 + lane * 4); }
    constexpr int N_SSM = 256, N_LN = MPAD / 8, T_WIN = 32 * 16, T_WGLU = 16 * 4;
    constexpr int N_ITEMS = N_SSM + N_LN + T_WIN + T_WGLU;
    for (int it = blockIdx.x; it < N_ITEMS; it += gridDim.x) {
        if (it < N_SSM) { if (mask & 1) ssm_precompute(a, it >> 2, it & 3, smem); continue; }
        int j = it - N_SSM;
        if (j < N_LN) { if (mask & 2) ln0_rows(a, j, wid, lane, gg, bb); continue; }
        if (!(mask & 4)) continue;
        j -= N_LN;
        float* T = (float*)smem;
        if (j < T_WIN) { transpose_tile(a.w_in, DPROJ, (j >> 4) * 64, (j & 15) * 256, (bf16_t*)(a.ws + OFF_WIN), 2048, RowMap{0}, T); continue; }
        j -= T_WIN;
        transpose_tile(a.w_glu, 1024, (j >> 2) * 64, (j & 3) * 256, (bf16_t*)(a.ws + OFF_WGLU), 1024, RowMap{0}, T);
    }
}
__device__ __forceinline__ TileDesc side_desc(CArgs& a, int kind, int j) {
    constexpr int T_G = 32 * 22;
    TileDesc d; d.kscale = nullptr;
    if (kind == 1) { d.src = a.w_down; d.ld = 2048; d.k0 = (j >> 3) * 64; d.n0 = (j & 7) * 256; d.dst = (bf16_t*)(a.ws + OFF_WDT); d.ldd = DFF; d.rm = RowMap{0}; return d; }
    if (j < 2 * T_G) { const bool up = j >= T_G; const int jj = up ? j - T_G : j; const int kt = jj / 22, nt = jj % 22;
        d.src = up ? a.w_up : a.w_gate; d.ld = DFF; d.k0 = kt * 64; d.n0 = nt * 256; d.dst = (bf16_t*)(a.ws + OFF_WGU); d.ldd = 2048; d.rm = RowMap{up ? 2 : 1}; return d; }
    const int jj = j - 2 * T_G;
    d.src = a.w_out; d.ld = 2048; d.k0 = (jj >> 3) * 64; d.n0 = (jj & 7) * 256; d.dst = (bf16_t*)(a.ws + OFF_WOUT); d.ldd = 2048; d.rm = RowMap{0}; d.kscale = d.k0 < 1024 ? a.g_ssm : nullptr; return d;
}
__device__ __forceinline__ void side_run(CArgs& a, int kind, int j0, int jend, int step, float* T) {
    for (int j = j0; j < jend; j += 2 * step) {
        const bool two = j + step < jend;
        const TileDesc dA = side_desc(a, kind, j), dB = side_desc(a, kind, two ? j + step : j);
        f32x4 vA[8], vB[8];
        tile_load(dA, vA);
        if (two) tile_load(dB, vB);
        tile_lds(dA, vA, T);
        if (two) tile_lds(dB, vB, T + 64 * 256);
        __syncthreads();
        tile_out(dA, T);
        if (two) tile_out(dB, T + 64 * 256);
        __syncthreads();
    }
}
__device__ __forceinline__ void side_transposes(CArgs& a, unsigned char* smem, int kind, int nunits, int busy_tiles) {
    const int G = (int)gridDim.x, rem = nunits % G, c = (int)blockIdx.x;
    constexpr int T_G = 32 * 22, T_WOUT = 32 * 8, T_WD = 88 * 8;
    const int total = kind == 0 ? 2 * T_G + T_WOUT : T_WD;
    float* T = (float*)smem;
    if (rem == 0) { side_run(a, kind, c, total, G, T); return; }
    const int n_idle = total - busy_tiles;
    if (c >= rem) side_run(a, kind, c - rem, n_idle, G - rem, T);
    else side_run(a, kind, n_idle + c, total, rem, T);
}

struct EpiProj { static constexpr bool PERM = true, AFTER_DRAIN = false, HAS_MID = false; bf16_t* O; int ldc; float* slab; bf16_t* ubuf;
    __device__ __forceinline__ void operator()(const f32x4 (&acc)[2][2][4][2], const pg8::Unit& u, int wr, int wc, int fr, int fq) const {
        const int col0 = u.pn * 256 + wc * 32 + 8 * fq;
        if (u.tail) {
            float* SL = slab + (size_t)(u.tail - 1) * 144 * DPROJ;
#pragma unroll
            for (int ai = 0; ai < 2; ++ai)
#pragma unroll
                for (int m = 0; m < 4; ++m) { const int rl = ai * 128 + wr * 64 + m * 16 + fr;
                    if (rl < 144) {
#pragma unroll
                        for (int bj = 0; bj < 2; ++bj) { float* p = SL + (size_t)rl * DPROJ + col0 + bj * 128; *(f32x4*)p = acc[ai][bj][m][0]; *(f32x4*)(p + 4) = acc[ai][bj][m][1]; } } }
            return; }
        const int row0 = u.pm * 256 + wr * 64 + fr;
        if (u.pn < 4) {
#pragma unroll
            for (int ai = 0; ai < 2; ++ai)
#pragma unroll
                for (int m = 0; m < 4; ++m) { const int row = row0 + ai * 128 + m * 16, n = row >> 11, tp = row & 2047;
#pragma unroll
                    for (int bj = 0; bj < 2; ++bj) { const int col = col0 + bj * 128; const f32x4 v0 = acc[ai][bj][m][0], v1 = acc[ai][bj][m][1];
                        u32x4 w; w.x = pk(v0[0], v0[1]); w.y = pk(v0[2], v0[3]); w.z = pk(v1[0], v1[1]); w.w = pk(v1[2], v1[3]);
                        *(u32x4*)(ubuf + ((size_t)(n * 64 + (col >> 4)) * 2048 + tp) * 16 + (col & 15)) = w; } }
            return; }
#pragma unroll
        for (int ai = 0; ai < 2; ++ai)
#pragma unroll
            for (int m = 0; m < 4; ++m) { bf16_t* rowp = O + (size_t)(row0 + ai * 128 + m * 16) * ldc + col0;
#pragma unroll
                for (int bj = 0; bj < 2; ++bj) { const f32x4 v0 = acc[ai][bj][m][0], v1 = acc[ai][bj][m][1];
                    u32x4 w; w.x = pk(v0[0], v0[1]); w.y = pk(v0[2], v0[3]); w.z = pk(v1[0], v1[1]); w.w = pk(v1[2], v1[3]);
                    *(u32x4*)(rowp + bj * 128) = w; } }
    }
};
struct EpiGlu { static constexpr bool PERM = true, AFTER_DRAIN = false, HAS_MID = false; const bf16_t* Y; bf16_t* O; float* rowsq;
    __device__ __forceinline__ void operator()(const f32x4 (&acc)[2][2][4][2], const pg8::Unit& u, int wr, int wc, int fr, int fq) const {
        const int row0 = u.pm * 256 + wr * 64 + fr, col0 = u.pn * 256 + wc * 32 + 8 * fq;
#pragma unroll
        for (int ai = 0; ai < 2; ++ai) {
            u32x4 yv[4][2];
#pragma unroll
            for (int m = 0; m < 4; ++m)
#pragma unroll
                for (int bj = 0; bj < 2; ++bj) yv[m][bj] = *(const u32x4*)(Y + (size_t)(row0 + ai * 128 + m * 16) * 1024 + col0 + bj * 128);
#pragma unroll
            for (int m = 0; m < 4; ++m) { const int row = row0 + ai * 128 + m * 16; float ss = 0.f;
#pragma unroll
                for (int bj = 0; bj < 2; ++bj) { const f32x4 z0 = acc[ai][bj][m][0], z1 = acc[ai][bj][m][1]; const u32x4 y = yv[m][bj];
                    float o[8];
                    o[0] = bflo(y.x) * sigmoidf_(z0[0]); o[1] = bfhi(y.x) * sigmoidf_(z0[1]); o[2] = bflo(y.y) * sigmoidf_(z0[2]); o[3] = bfhi(y.y) * sigmoidf_(z0[3]);
                    o[4] = bflo(y.z) * sigmoidf_(z1[0]); o[5] = bfhi(y.z) * sigmoidf_(z1[1]); o[6] = bflo(y.w) * sigmoidf_(z1[2]); o[7] = bfhi(y.w) * sigmoidf_(z1[3]);
#pragma unroll
                    for (int e = 0; e < 8; ++e) ss += o[e] * o[e];
                    u32x4 w; w.x = pk(o[0], o[1]); w.y = pk(o[2], o[3]); w.z = pk(o[4], o[5]); w.w = pk(o[6], o[7]);
                    *(u32x4*)(O + (size_t)row * 2048 + col0 + bj * 128) = w; }
                ss += __shfl_xor(ss, 16); ss += __shfl_xor(ss, 32);
                if (fq == 0 && row < MROWS) atomicAdd(rowsq + row, ss); }
        }
    }
};
__device__ __forceinline__ float rms_scale(const float* rowsq, int row) { return rsqrtf(rowsq[row] * (1.0f / 1024.0f) + 1e-6f); }
template <bool MID> struct EpiRes { static constexpr bool PERM = true, AFTER_DRAIN = false, HAS_MID = MID; const bf16_t* X; bf16_t* Z; float* slab; const float* rowsq; int mid_t;
    __device__ __forceinline__ void mid(f32x4 (&acc)[2][2][4][2], const pg8::Unit& u, int wr, int fr) const {
        const float* rp = rowsq + (u.pm * 256 + wr * 64 + fr);
        float q[2][4];
#pragma unroll
        for (int ai = 0; ai < 2; ++ai)
#pragma unroll
            for (int m = 0; m < 4; ++m) q[ai][m] = rp[ai * 128 + m * 16];
        __builtin_amdgcn_sched_barrier(0);
#pragma unroll
        for (int ai = 0; ai < 2; ++ai)
#pragma unroll
            for (int m = 0; m < 4; ++m) { const float rs = rsqrtf(q[ai][m] * (1.0f / 1024.0f) + 1e-6f);
#pragma unroll
                for (int bj = 0; bj < 2; ++bj)
#pragma unroll
                    for (int n = 0; n < 2; ++n) acc[ai][bj][m][n] *= rs; }
    }
    __device__ __forceinline__ void operator()(const f32x4 (&acc)[2][2][4][2], const pg8::Unit& u, int wr, int wc, int fr, int fq) const {
        const int col0 = u.pn * 256 + wc * 32 + 8 * fq;
        if (u.tail) {
            float* SL = slab + (size_t)(u.tail - 1) * 128 * 2048;
            float rsv[4] = {1.0f, 1.0f, 1.0f, 1.0f};
            if (MID && (u.kt0 < mid_t)) {
#pragma unroll
                for (int m = 0; m < 4; ++m) rsv[m] = rms_scale(rowsq, 8192 + wr * 64 + m * 16 + fr); }
#pragma unroll
            for (int m = 0; m < 4; ++m) { const int rl = wr * 64 + m * 16 + fr; const float rs = rsv[m];
#pragma unroll
                for (int bj = 0; bj < 2; ++bj) { float* p = SL + (size_t)rl * 2048 + col0 + bj * 128; *(f32x4*)p = acc[0][bj][m][0] * rs; *(f32x4*)(p + 4) = acc[0][bj][m][1] * rs; } }
            return; }
        const int row0 = u.pm * 256 + wr * 64 + fr;
#pragma unroll
        for (int ai = 0; ai < 2; ++ai) {
            u32x4 xv[4][2];
#pragma unroll
            for (int m = 0; m < 4; ++m)
#pragma unroll
                for (int bj = 0; bj < 2; ++bj) xv[m][bj] = *(const u32x4*)(X + (size_t)(row0 + ai * 128 + m * 16) * 2048 + col0 + bj * 128);
#pragma unroll
            for (int m = 0; m < 4; ++m) { const int row = row0 + ai * 128 + m * 16;
#pragma unroll
                for (int bj = 0; bj < 2; ++bj) { const u32x4 x = xv[m][bj]; const f32x4 c0 = acc[ai][bj][m][0], c1 = acc[ai][bj][m][1];
                    u32x4 w; w.x = pk(ALPHA * bflo(x.x) + c0[0], ALPHA * bfhi(x.x) + c0[1]); w.y = pk(ALPHA * bflo(x.y) + c0[2], ALPHA * bfhi(x.y) + c0[3]);
                    w.z = pk(ALPHA * bflo(x.z) + c1[0], ALPHA * bfhi(x.z) + c1[1]); w.w = pk(ALPHA * bflo(x.w) + c1[2], ALPHA * bfhi(x.w) + c1[3]);
                    *(u32x4*)(Z + (size_t)row * 2048 + col0 + bj * 128) = w; } }
        }
    }
};
struct EpiGateUp { static constexpr bool PERM = true, AFTER_DRAIN = false, HAS_MID = false; bf16_t* O;
    __device__ __forceinline__ void operator()(const f32x4 (&acc)[2][2][4][2], const pg8::Unit& u, int wr, int wc, int fr, int fq) const {
        const int row0 = u.pm * 256 + wr * 64 + fr, col0 = u.pn * 128 + wc * 32 + 8 * fq;
#pragma unroll
        for (int ai = 0; ai < 2; ++ai)
#pragma unroll
            for (int m = 0; m < 4; ++m) { const int row = row0 + ai * 128 + m * 16; float h[8];
#pragma unroll
                for (int n = 0; n < 2; ++n)
#pragma unroll
                    for (int e = 0; e < 4; ++e) { const float gt = acc[ai][0][m][n][e], up = acc[ai][1][m][n][e]; h[n * 4 + e] = gt * sigmoidf_(gt) * up; }
                u32x4 w; w.x = pk(h[0], h[1]); w.y = pk(h[2], h[3]); w.z = pk(h[4], h[5]); w.w = pk(h[6], h[7]);
                *(u32x4*)(O + (size_t)row * DFF + col0) = w; }
    }
};


struct TailOrder {
    pg8::StaticOrder so; int nmain, nN, S, ktiles, nMm;
    __device__ void init(int nMm_, int N, int ktiles_, int S_, int G, int c) { nMm = nMm_; so.init(nMm_ * 256, N, G, c); so.ktiles = ktiles_; nmain = so.nwg; nN = N / 256; S = S_; ktiles = ktiles_; }
    __device__ bool next(int i, pg8::Unit& u) const {
        const int L = i * so.G + so.c;
        if (L < nmain) return so.next(i, u);
        const int idx = L - nmain; if (idx >= nN * S) return false;
        const int s = idx / nN; u.pm = nMm; u.pn = idx - s * nN; u.nkt = ktiles / S; u.kt0 = s * u.nkt; u.tail = s + 1; return true;
    }
    __device__ __forceinline__ void a_ready(const pg8::Unit&) const {}
    __device__ __forceinline__ void done(const pg8::Unit&) const {}
};
template <class Epi, bool ALIGN = false> __device__ __forceinline__ void run_gemm(unsigned char* smem, const bf16_t* A, const bf16_t* Bt, int M, int N, int K, const Epi& E) {
    pg8::Gemm g; g.A = A; g.Bt = Bt; g.M = M; g.N = N; g.K = K;
    pg8::StaticOrder S; S.init(M, N, (int)gridDim.x, (int)blockIdx.x); S.ktiles = K / 64;
    pg8::gemm_phase<Epi, pg8::StaticOrder, false, true, ALIGN>((PG8_LAS unsigned char*)smem, g, S, E, nullptr);
}
template <class Epi> __device__ __forceinline__ void run_gemm_tail(unsigned char* smem, const bf16_t* A, const bf16_t* Bt, int N, int K, int S_, const Epi& E) {
    pg8::Gemm g; g.A = A; g.Bt = Bt; g.M = MPAD; g.N = N; g.K = K;
    TailOrder S; S.init(32, N, K / 64, S_, (int)gridDim.x, (int)blockIdx.x);
    pg8::gemm_phase<Epi, TailOrder, false, true, true>((PG8_LAS unsigned char*)smem, g, S, E, nullptr);
}

__device__ __forceinline__ void unpack8(const u32x4 v, float (&o)[8]) { o[0] = bflo(v.x); o[1] = bfhi(v.x); o[2] = bflo(v.y); o[3] = bfhi(v.y); o[4] = bflo(v.z); o[5] = bfhi(v.z); o[6] = bflo(v.w); o[7] = bfhi(v.w); }

__device__ __forceinline__ void proj8(CArgs& a, int row, int col, float (&v)[8]) { unpack8(*(const u32x4*)((const bf16_t*)(a.ws + OFF_PROJ) + (size_t)row * DPROJ + col), v); }
__device__ __forceinline__ void phase_tail_reduce(CArgs& a) {
    const int per = (144 * 512 + (int)gridDim.x - 1) / (int)gridDim.x, t_ = tid_();
    for (int i = blockIdx.x * per + t_; t_ < per && i < 144 * 512 && i < (blockIdx.x + 1) * per; i += 512) {
        const int rl = i >> 9, c8 = (i & 511) * 8;
        const float* SL = (const float*)(a.ws + OFF_SLAB) + (size_t)rl * DPROJ + c8;
        f32x4 s0 = *(const f32x4*)SL, s1 = *(const f32x4*)(SL + 4);
#pragma unroll
        for (int s = 1; s < S_PROJ; ++s) { s0 += *(const f32x4*)(SL + (size_t)s * 144 * DPROJ); s1 += *(const f32x4*)(SL + (size_t)s * 144 * DPROJ + 4); }
        u32x4 w; w.x = pk(s0[0], s0[1]); w.y = pk(s0[2], s0[3]); w.z = pk(s1[0], s1[1]); w.w = pk(s1[2], s1[3]);
        *(u32x4*)((bf16_t*)(a.ws + OFF_PROJ) + (size_t)(8192 + rl) * DPROJ + c8) = w;
    }
}
constexpr int USTR = 528;
__device__ __forceinline__ void ssm_item(CArgs& a, int n, int g, unsigned char* smem) {
    unsigned char* U = smem;
    unsigned char* S = smem + 144 * USTR;
    const int tid = tid_(), wid = tid >> 6, lane = tid & 63, fr = lane & 15, fq = lane >> 4;
    const bf16_t* PROJ = (const bf16_t*)(a.ws + OFF_PROJ);
    const bf16_t* UB = (const bf16_t*)a.out + (size_t)(n * 64 + g) * 2048 * 16;
    const bf16_t* FT = (const bf16_t*)(a.ws + OFF_SSMF) + (size_t)g * 128 * 256 + (size_t)(wid * 16 + fr) * 256 + fq * 8;
    bf16x8 bfr[8];
#pragma unroll
    for (int kk = 0; kk < 8; ++kk) bfr[kk] = *(const bf16x8*)(FT + kk * 32);
    {
        u32x4 v[9];
#pragma unroll
        for (int q = 0; q < 9; ++q) { const int i = tid + q * 512, ch = i >> 5, j = (i >> 1) & 15, hh = i & 1;
            v[q] = (u32x4){0u, 0u, 0u, 0u};
            if (ch == 0) v[q] = *(const u32x4*)(PROJ + (size_t)(META0 + j) * DPROJ + g * 16 + hh * 8);
            else if (ch < 129) v[q] = __builtin_nontemporal_load((const u32x4*)(UB + (size_t)(i - 32) * 8)); }
#pragma unroll
        for (int q = 0; q < 9; ++q) { const int i = tid + q * 512, ch = i >> 5, j = (i >> 1) & 15, hh = i & 1; *(u32x4*)(U + ch * USTR + j * 32 + hh * 16) = v[q]; }
    }
    __syncthreads();
    {
#pragma unroll 1
        for (int m3 = 0; m3 < 3; ++m3) {
            f32x4 acc[3];
#pragma unroll
            for (int q = 0; q < 3; ++q) acc[q] = (f32x4){0.f, 0.f, 0.f, 0.f};
#pragma unroll
            for (int kk = 0; kk < 8; ++kk)
#pragma unroll
                for (int q = 0; q < 3; ++q) { const bf16x8 av = *(const bf16x8*)(U + ((m3 * 3 + q) * 16 + fr) * USTR + (kk * 32 + fq * 8) * 2); acc[q] = __builtin_amdgcn_mfma_f32_16x16x32_bf16(av, bfr[kk], acc[q], 0, 0, 0); }
#pragma unroll
            for (int q = 0; q < 3; ++q)
#pragma unroll
                for (int j = 0; j < 4; ++j) *(float*)(S + ((m3 * 3 + q) * 16 + fq * 4 + j) * USTR + (wid * 16 + fr) * 4) = acc[q][j];
        }
    }
    const bf16_t* MEw = (const bf16_t*)(a.ws + OFF_SSMME) + (size_t)g * 256 * 384 + (size_t)(wid * 32 + fr) * 384 + fq * 8;
    bf16x8 bm0[12], bm1[12];
#pragma unroll
    for (int kk = 0; kk < 12; ++kk) { bm0[kk] = *(const bf16x8*)(MEw + kk * 32); bm1[kk] = *(const bf16x8*)(MEw + 16 * 384 + kk * 32); }
    __syncthreads();
    {
        const float* SC = (const float*)(a.ws + OFF_SSMC) + (size_t)g * 2304;
        const float ar = SC[128 + lane], ai = SC[192 + lane];
        float pr[17], pi[17];
        pr[0] = 0.f; pi[0] = 0.f;
#pragma unroll
        for (int k = 0; k < 16; ++k) { const int ch = wid * 16 + k;
            const float lr = *(const float*)(S + ch * USTR + lane * 4), li = *(const float*)(S + ch * USTR + 256 + lane * 4);
            pr[k + 1] = ar * pr[k] - ai * pi[k] + lr; pi[k + 1] = ar * pi[k] + ai * pr[k] + li; }
        const float l128r = *(const float*)(S + 128 * USTR + lane * 4), l128i = *(const float*)(S + 128 * USTR + 256 + lane * 4);
        float* E = (float*)(S + (136 + wid) * USTR);
        E[lane] = pr[16]; E[64 + lane] = pi[16];
        __syncthreads();
        float a2r = ar, a2i = ai;
#pragma unroll
        for (int q = 0; q < 4; ++q) { const float tr = a2r * a2r - a2i * a2i, ti = 2.f * a2r * a2i; a2r = tr; a2i = ti; }
        float cr = 0.f, ci = 0.f;
        for (int v = 0; v < wid; ++v) { const float* Ev = (const float*)(S + (136 + v) * USTR); const float er = Ev[lane], ei = Ev[64 + lane];
            const float tr = a2r * cr - a2i * ci + er, ti = a2r * ci + a2i * cr + ei; cr = tr; ci = ti; }
#pragma unroll
        for (int k = 0; k < 16; ++k) { const int ch = wid * 16 + k;
            *(bf16_t*)(S + ch * USTR + lane * 2) = (bf16_t)(pk(pr[k] + cr, 0.f) & 0xffffu);
            *(bf16_t*)(S + ch * USTR + 128 + lane * 2) = (bf16_t)(pk(pi[k] + ci, 0.f) & 0xffffu);
            const float tr = ar * cr - ai * ci, ti = ar * ci + ai * cr; cr = tr; ci = ti; }
        if (wid == 7) {
            const float sr = pr[16] + cr, si = pi[16] + ci;
            *(bf16_t*)(S + 128 * USTR + lane * 2) = (bf16_t)(pk(sr, 0.f) & 0xffffu);
            *(bf16_t*)(S + 128 * USTR + 128 + lane * 2) = (bf16_t)(pk(si, 0.f) & 0xffffu);
            a.out[O_PRE + (size_t)(n * 64 + g) * 64 + lane] = ar * sr - ai * si + l128r;
            a.out[O_PIM + (size_t)(n * 64 + g) * 64 + lane] = ar * si + ai * sr + l128i;
        }
    }
    __syncthreads();
    {
        const f32x4 dsk = *(const f32x4*)(a.ssm_d + g * 16 + fq * 4);
        bf16_t* YA = (bf16_t*)(a.ws + OFF_YACT);
#pragma unroll 1
        for (int mt = 0; mt < 9; ++mt) {
            f32x4 acc0 = (f32x4){0.f, 0.f, 0.f, 0.f}, acc1 = (f32x4){0.f, 0.f, 0.f, 0.f};
#pragma unroll
            for (int kk = 0; kk < 8; ++kk) if (kk <= wid) { const bf16x8 uv = *(const bf16x8*)(U + (mt * 16 + fr) * USTR + (kk * 32 + fq * 8) * 2);
                acc0 = __builtin_amdgcn_mfma_f32_16x16x32_bf16(bm0[kk], uv, acc0, 0, 0, 0); acc1 = __builtin_amdgcn_mfma_f32_16x16x32_bf16(bm1[kk], uv, acc1, 0, 0, 0); }
#pragma unroll
            for (int kk = 0; kk < 4; ++kk) { const bf16x8 sv = *(const bf16x8*)(S + (mt * 16 + fr) * USTR + (kk * 32 + fq * 8) * 2);
                acc0 = __builtin_amdgcn_mfma_f32_16x16x32_bf16(bm0[8 + kk], sv, acc0, 0, 0, 0); acc1 = __builtin_amdgcn_mfma_f32_16x16x32_bf16(bm1[8 + kk], sv, acc1, 0, 0, 0); }
            const int ch = mt * 16 + fr;
            if (ch >= 1 && ch < 129) {
#pragma unroll
                for (int ti = 0; ti < 2; ++ti) { const int t = wid * 2 + ti; const f32x4 acc = ti ? acc1 : acc0;
                    const u32x2 ur = *(const u32x2*)(U + ch * USTR + (t * 16 + fq * 4) * 2);
                    const float y0 = gelu_tanh(acc[0] + dsk[0] * bflo(ur.x)), y1 = gelu_tanh(acc[1] + dsk[1] * bfhi(ur.x)), y2 = gelu_tanh(acc[2] + dsk[2] * bflo(ur.y)), y3 = gelu_tanh(acc[3] + dsk[3] * bfhi(ur.y));
                    *(u32x2*)(YA + (size_t)(n * 2048 + (ch - 1) * 16 + t) * 1024 + g * 16 + fq * 4) = (u32x2){pk(y0, y1), pk(y2, y3)}; }
            }
        }
    }
    __syncthreads();
}

__device__ __forceinline__ void sample_ssm_quad(CArgs& a, int b0, int g, int lane) {
    const float* SC = (const float*)(a.ws + OFF_SSMC) + (size_t)g * 2304;
    const bf16_t* PROJ = (const bf16_t*)(a.ws + OFF_PROJ) + (size_t)(8192 + b0) * DPROJ + g * 16;
    u32x4 ur[4][2]; float s0r[4], s0i[4];
#pragma unroll
    for (int i = 0; i < 4; ++i) { ur[i][0] = *(const u32x4*)(PROJ + (size_t)i * DPROJ); ur[i][1] = *(const u32x4*)(PROJ + (size_t)i * DPROJ + 8);
        const size_t so = (size_t)((b0 + i) * 64 + g) * 64 + lane; s0r[i] = a.st_re[so]; s0i[i] = a.st_im[so]; }
    f32x4 br[4], bi[4], cr4[4], ci4[4];
#pragma unroll
    for (int q = 0; q < 4; ++q) { br[q] = *(const f32x4*)(SC + 256 + lane * 16 + q * 4); bi[q] = *(const f32x4*)(SC + 1280 + lane * 16 + q * 4); }
    const int c = lane & 15, qq = lane >> 4;
    { const float* crp = a.c_re + (size_t)(g * 16 + c) * 64 + qq * 16; const float* cip = a.c_im + (size_t)(g * 16 + c) * 64 + qq * 16;
#pragma unroll
      for (int k = 0; k < 4; ++k) { cr4[k] = *(const f32x4*)(crp + 4 * k); ci4[k] = *(const f32x4*)(cip + 4 * k); } }
    const float ar = SC[lane], ai = SC[64 + lane], dsk = a.ssm_d[g * 16 + c];
#pragma unroll
    for (int i = 0; i < 4; ++i) {
        float uu[16]; { float f[8]; unpack8(ur[i][0], f);
#pragma unroll
            for (int e = 0; e < 8; ++e) uu[e] = f[e];
            unpack8(ur[i][1], f);
#pragma unroll
            for (int e = 0; e < 8; ++e) uu[8 + e] = f[e]; }
        float xr = 0.f, xi = 0.f;
#pragma unroll
        for (int q = 0; q < 4; ++q)
#pragma unroll
            for (int e = 0; e < 4; ++e) { xr += br[q][e] * uu[q * 4 + e]; xi += bi[q][e] * uu[q * 4 + e]; }
        const float sr = ar * s0r[i] - ai * s0i[i] + xr, si = ar * s0i[i] + ai * s0r[i] + xi;
        const size_t so = (size_t)((b0 + i) * 64 + g) * 64 + lane;
        a.out[O_SRE + so] = sr; a.out[O_SIM + so] = si;
        float part = 0.f;
#pragma unroll
        for (int k = 0; k < 16; ++k) { const float spr = __shfl(sr, qq * 16 + k), spi = __shfl(si, qq * 16 + k); part += cr4[k >> 2][k & 3] * spr - ci4[k >> 2][k & 3] * spi; }
        part += __shfl_xor(part, 16); part += __shfl_xor(part, 32);
        float uc = 0.f;
#pragma unroll
        for (int e = 0; e < 16; ++e) uc = (c == e) ? uu[e] : uc;
        const float y = gelu_tanh(part + dsk * uc);
        if (lane < 16) ((bf16_t*)(a.ws + OFF_YACT))[(size_t)(8192 + b0 + i) * 1024 + g * 16 + lane] = (bf16_t)(pk(y, 0.f) & 0xffffu);
    }
}

__device__ __forceinline__ void load_v8(CArgs& a, int row, int j, float (&v)[8]) {
    float c[8], h[8]; proj8(a, row, 2048 + j, c); proj8(a, row, 3072 + j, h);
#pragma unroll
    for (int e = 0; e < 8; ++e) v[e] = c[e] * h[e];
}
__device__ __forceinline__ void conv_row(CArgs& a, int r, int lane) {
    float y[2][8], vcur[2][8]; float ss = 0.f;
    f32x4 q1[2][2], gv[2][2];
    const bool smp = r >= 8192;
#pragma unroll
    for (int hh = 0; hh < 2; ++hh) {
        const int j = hh * 512 + lane * 8;
        float v1[8], v2[8], bg[8];
        load_v8(a, r, j, vcur[hh]);
        proj8(a, r, 1024 + j, bg);
        if (!smp) { const int tp = r & 2047; const int r1 = tp >= 1 ? r - 1 : META0 + 15, r2 = tp >= 2 ? r - 2 : META0 + 14 + tp;
            load_v8(a, r1, j, v1); load_v8(a, r2, j, v2);
        } else { const float* sc = a.st_conv + (size_t)(r - 8192) * 2048 + j;
            const f32x4 p0 = *(const f32x4*)sc, p1 = *(const f32x4*)(sc + 4); q1[hh][0] = *(const f32x4*)(sc + 1024); q1[hh][1] = *(const f32x4*)(sc + 1028);
#pragma unroll
            for (int e = 0; e < 4; ++e) { v2[e] = p0[e]; v2[4 + e] = p1[e]; v1[e] = q1[hh][0][e]; v1[4 + e] = q1[hh][1][e]; } }
        const f32x4 w0a = *(const f32x4*)(a.conv_w + j), w0b = *(const f32x4*)(a.conv_w + j + 4), w1a = *(const f32x4*)(a.conv_w + 1024 + j), w1b = *(const f32x4*)(a.conv_w + 1024 + j + 4),
                    w2a = *(const f32x4*)(a.conv_w + 2048 + j), w2b = *(const f32x4*)(a.conv_w + 2048 + j + 4);
        gv[hh][0] = *(const f32x4*)(a.g_conv + j); gv[hh][1] = *(const f32x4*)(a.g_conv + j + 4);
#pragma unroll
        for (int e = 0; e < 8; ++e) { const float w0 = e < 4 ? w0a[e & 3] : w0b[e & 3], w1 = e < 4 ? w1a[e & 3] : w1b[e & 3], w2 = e < 4 ? w2a[e & 3] : w2b[e & 3];
            const float cv = w0 * v2[e] + w1 * v1[e] + w2 * vcur[hh][e]; y[hh][e] = bg[e] * cv; ss += y[hh][e] * y[hh][e]; }
    }
    const float rr = rsqrtf(wave_sum(ss) * (1.0f / 1024.0f) + 1e-6f);
    bf16_t* MG = (bf16_t*)(a.ws + OFF_MERGED) + (size_t)r * 2048 + 1024;
#pragma unroll
    for (int hh = 0; hh < 2; ++hh) { const int j = hh * 512 + lane * 8; const f32x4 ga = gv[hh][0], gb = gv[hh][1];
        u32x4 w; w.x = pk(y[hh][0] * rr * ga[0], y[hh][1] * rr * ga[1]); w.y = pk(y[hh][2] * rr * ga[2], y[hh][3] * rr * ga[3]); w.z = pk(y[hh][4] * rr * gb[0], y[hh][5] * rr * gb[1]); w.w = pk(y[hh][6] * rr * gb[2], y[hh][7] * rr * gb[3]);
        *(u32x4*)(MG + j) = w;
        if (smp) { float* o = a.out + O_SCV + (size_t)(r - 8192) * 2048 + j; *(f32x4*)o = q1[hh][0]; *(f32x4*)(o + 4) = q1[hh][1];
            *(f32x4*)(o + 1024) = (f32x4){vcur[hh][0], vcur[hh][1], vcur[hh][2], vcur[hh][3]}; *(f32x4*)(o + 1028) = (f32x4){vcur[hh][4], vcur[hh][5], vcur[hh][6], vcur[hh][7]}; } }
}
template <int NR> __device__ __forceinline__ void conv_rows(CArgs& a, int r0, int lane) {
    const int tp0 = r0 & 2047;
    const bf16_t* PR = (const bf16_t*)(a.ws + OFF_PROJ) + (size_t)(r0 - 2) * DPROJ;
    float y[NR][2][8]; float ss[NR];
#pragma unroll
    for (int i = 0; i < NR; ++i) ss[i] = 0.f;
#pragma unroll
    for (int hh = 0; hh < 2; ++hh) {
        const int j = hh * 512 + lane * 8;
        float v[NR + 2][8], bg[NR][8];
        {
            u32x4 cc[NR + 2], hv[NR + 2], bb[NR];
#pragma unroll
            for (int i = 0; i < NR + 2; ++i) { cc[i] = *(const u32x4*)(PR + (size_t)i * DPROJ + 2048 + j); hv[i] = *(const u32x4*)(PR + (size_t)i * DPROJ + 3072 + j); }
#pragma unroll
            for (int i = 0; i < NR; ++i) bb[i] = *(const u32x4*)(PR + (size_t)(i + 2) * DPROJ + 1024 + j);
#pragma unroll
            for (int i = 0; i < NR + 2; ++i) { float c[8], h[8]; unpack8(cc[i], c); unpack8(hv[i], h);
#pragma unroll
                for (int e = 0; e < 8; ++e) v[i][e] = c[e] * h[e]; }
#pragma unroll
            for (int i = 0; i < NR; ++i) unpack8(bb[i], bg[i]);
        }
        const f32x4 w0a = *(const f32x4*)(a.conv_w + j), w0b = *(const f32x4*)(a.conv_w + j + 4), w1a = *(const f32x4*)(a.conv_w + 1024 + j), w1b = *(const f32x4*)(a.conv_w + 1024 + j + 4),
                    w2a = *(const f32x4*)(a.conv_w + 2048 + j), w2b = *(const f32x4*)(a.conv_w + 2048 + j + 4);
        if (tp0 + NR == 2048) {
#pragma unroll
            for (int i = NR - 2; i < NR; ++i) { float* o = a.out + O_PCV + (size_t)((r0 >> 11) * 2 + (i - (NR - 2))) * 1024 + j; *(f32x4*)o = (f32x4){v[2 + i][0], v[2 + i][1], v[2 + i][2], v[2 + i][3]}; *(f32x4*)(o + 4) = (f32x4){v[2 + i][4], v[2 + i][5], v[2 + i][6], v[2 + i][7]}; } }
#pragma unroll
        for (int i = 0; i < NR; ++i)
#pragma unroll
            for (int e = 0; e < 8; ++e) { const float w0 = e < 4 ? w0a[e & 3] : w0b[e & 3], w1 = e < 4 ? w1a[e & 3] : w1b[e & 3], w2 = e < 4 ? w2a[e & 3] : w2b[e & 3];
                const float cv = w0 * v[i][e] + w1 * v[i + 1][e] + w2 * v[i + 2][e]; const float yy = bg[i][e] * cv; y[i][hh][e] = yy; ss[i] += yy * yy; }
    }
#pragma unroll
    for (int i = 0; i < NR; ++i) {
        const float rr = rsqrtf(wave_sum(ss[i]) * (1.0f / 1024.0f) + 1e-6f);
        bf16_t* MG = (bf16_t*)(a.ws + OFF_MERGED) + (size_t)(r0 + i) * 2048 + 1024;
#pragma unroll
        for (int hh = 0; hh < 2; ++hh) { const int j = hh * 512 + lane * 8; const f32x4 ga = *(const f32x4*)(a.g_conv + j), gb = *(const f32x4*)(a.g_conv + j + 4);
            u32x4 w; w.x = pk(y[i][hh][0] * rr * ga[0], y[i][hh][1] * rr * ga[1]); w.y = pk(y[i][hh][2] * rr * ga[2], y[i][hh][3] * rr * ga[3]);
            w.z = pk(y[i][hh][4] * rr * gb[0], y[i][hh][5] * rr * gb[1]); w.w = pk(y[i][hh][6] * rr * gb[2], y[i][hh][7] * rr * gb[3]);
            *(u32x4*)(MG + j) = w; }
    }
}

__device__ __forceinline__ void conv_rows4_lds(CArgs& a, int r0, int lane, float* Y) {
    const int tp0 = r0 & 2047;
    const bf16_t* PR = (const bf16_t*)(a.ws + OFF_PROJ) + (size_t)(r0 - 2) * DPROJ;
    float ss[4] = {0.f, 0.f, 0.f, 0.f};
#pragma unroll
    for (int hh = 0; hh < 2; ++hh) {
        const int j = hh * 512 + lane * 8;
        float v[6][8], bg[4][8];
        {
            u32x4 cc[6], hv[6], bb[4];
#pragma unroll
            for (int i = 0; i < 6; ++i) { cc[i] = __builtin_nontemporal_load((const u32x4*)(PR + (size_t)i * DPROJ + 2048 + j)); hv[i] = __builtin_nontemporal_load((const u32x4*)(PR + (size_t)i * DPROJ + 3072 + j)); }
#pragma unroll
            for (int i = 0; i < 4; ++i) bb[i] = __builtin_nontemporal_load((const u32x4*)(PR + (size_t)(i + 2) * DPROJ + 1024 + j));
#pragma unroll
            for (int i = 0; i < 6; ++i) { float c[8], h[8]; unpack8(cc[i], c); unpack8(hv[i], h);
#pragma unroll
                for (int e = 0; e < 8; ++e) v[i][e] = c[e] * h[e]; }
#pragma unroll
            for (int i = 0; i < 4; ++i) unpack8(bb[i], bg[i]);
        }
        const f32x4 w0a = *(const f32x4*)(a.conv_w + j), w0b = *(const f32x4*)(a.conv_w + j + 4), w1a = *(const f32x4*)(a.conv_w + 1024 + j), w1b = *(const f32x4*)(a.conv_w + 1024 + j + 4),
                    w2a = *(const f32x4*)(a.conv_w + 2048 + j), w2b = *(const f32x4*)(a.conv_w + 2048 + j + 4);
        if (tp0 == 2044) {
#pragma unroll
            for (int i = 2; i < 4; ++i) { float* o = a.out + O_PCV + (size_t)((r0 >> 11) * 2 + (i - 2)) * 1024 + j; *(f32x4*)o = (f32x4){v[2 + i][0], v[2 + i][1], v[2 + i][2], v[2 + i][3]}; *(f32x4*)(o + 4) = (f32x4){v[2 + i][4], v[2 + i][5], v[2 + i][6], v[2 + i][7]}; } }
#pragma unroll
        for (int i = 0; i < 4; ++i) { f32x4 y0, y1;
#pragma unroll
            for (int e = 0; e < 8; ++e) { const float w0 = e < 4 ? w0a[e & 3] : w0b[e & 3], w1 = e < 4 ? w1a[e & 3] : w1b[e & 3], w2 = e < 4 ? w2a[e & 3] : w2b[e & 3];
                const float yy = bg[i][e] * (w0 * v[i][e] + w1 * v[i + 1][e] + w2 * v[i + 2][e]); ss[i] += yy * yy; if (e < 4) y0[e & 3] = yy; else y1[e & 3] = yy; }
            float* yp = Y + ((i * 2 + hh) * 64 + lane) * 8; *(f32x4*)yp = y0; *(f32x4*)(yp + 4) = y1; }
    }
    f32x4 gv[2][2];
#pragma unroll
    for (int hh = 0; hh < 2; ++hh) { gv[hh][0] = *(const f32x4*)(a.g_conv + hh * 512 + lane * 8); gv[hh][1] = *(const f32x4*)(a.g_conv + hh * 512 + lane * 8 + 4); }
#pragma unroll
    for (int i = 0; i < 4; ++i) {
        const float rr = rsqrtf(wave_sum(ss[i]) * (1.0f / 1024.0f) + 1e-6f);
        bf16_t* MG = (bf16_t*)(a.ws + OFF_MERGED) + (size_t)(r0 + i) * 2048 + 1024;
#pragma unroll
        for (int hh = 0; hh < 2; ++hh) { const int j = hh * 512 + lane * 8; const f32x4 ga = gv[hh][0], gb = gv[hh][1];
            const float* yp = Y + ((i * 2 + hh) * 64 + lane) * 8; const f32x4 y0 = *(const f32x4*)yp, y1 = *(const f32x4*)(yp + 4);
            u32x4 w; w.x = pk(y0[0] * rr * ga[0], y0[1] * rr * ga[1]); w.y = pk(y0[2] * rr * ga[2], y0[3] * rr * ga[3]); w.z = pk(y1[0] * rr * gb[0], y1[1] * rr * gb[1]); w.w = pk(y1[2] * rr * gb[2], y1[3] * rr * gb[3]);
            *(u32x4*)(MG + j) = w; }
    }
}

__device__ __forceinline__ void phase_mixers(CArgs& a, unsigned char* smem, int mask = 7) {
    const int tid = tid_(), wid = tid >> 6, lane = tid & 63;
    if (mask & 1) for (int it = blockIdx.x; it < 256; it += gridDim.x) ssm_item(a, it >> 6, it & 63, smem);
    const int gw = blockIdx.x * 8 + wid, nw = gridDim.x * 8;
    if (mask & 2) for (int it = gw; it < 32 * 64; it += nw) sample_ssm_quad(a, (it >> 6) * 4, it & 63, lane);
    if (mask & 4) {
        for (int t = gw; t < 2048; t += nw) if ((t & 511) != 0) conv_rows4_lds(a, t * 4, lane, (float*)(smem + wid * 16384));
        const int sstr = nw / 144;
        if (sstr >= 1) { if (gw % sstr == 0 && gw / sstr < 144) { const int q = gw / sstr; if (q < 128) conv_row(a, 8192 + q, lane); else conv_row(a, ((q - 128) >> 2) * 2048 + ((q - 128) & 3), lane); } }
        else for (int q = gw; q < 144; q += nw) { if (q < 128) conv_row(a, 8192 + q, lane); else conv_row(a, ((q - 128) >> 2) * 2048 + ((q - 128) & 3), lane); }
    }
}

__device__ __forceinline__ void phase_norm_ssm(CArgs& a) {
    const int wid = tid_() >> 6, lane = tid_() & 63; const int gw = blockIdx.x * 8 + wid, nw = gridDim.x * 8;
    const float* rowsq = (const float*)(a.ws + OFF_ROWSQ);
    for (int r = gw; r < MROWS; r += nw) {
        const float rr = rsqrtf(rowsq[r] * (1.0f / 1024.0f) + 1e-6f);
        bf16_t* MG = (bf16_t*)(a.ws + OFF_MERGED) + (size_t)r * 2048;
#pragma unroll
        for (int hh = 0; hh < 2; ++hh) { const int j = hh * 512 + lane * 8; float v[8]; unpack8(*(const u32x4*)(MG + j), v);
            const f32x4 ga = *(const f32x4*)(a.g_ssm + j), gb = *(const f32x4*)(a.g_ssm + j + 4);
            u32x4 w; w.x = pk(v[0] * rr * ga[0], v[1] * rr * ga[1]); w.y = pk(v[2] * rr * ga[2], v[3] * rr * ga[3]); w.z = pk(v[4] * rr * gb[0], v[5] * rr * gb[1]); w.w = pk(v[6] * rr * gb[2], v[7] * rr * gb[3]);
            *(u32x4*)(MG + j) = w; }
    }
}
__device__ __forceinline__ void load_preln_row(CArgs& a, const bf16_t* Z, int r, int lane, int S, f32x4 (&v)[8]) {
    if (r < 8192) { const bf16_t* src = Z + (size_t)r * D;
#pragma unroll
        for (int i = 0; i < 8; ++i) { const u32x2 x = __builtin_nontemporal_load((const u32x2*)(src + i * 256 + lane * 4)); v[i] = (f32x4){bflo(x.x), bfhi(x.x), bflo(x.y), bfhi(x.y)}; }
        return; }
    const bf16_t* X = (const bf16_t*)(a.ws + OFF_X) + (size_t)r * D; const float* SL = (const float*)(a.ws + OFF_SLAB) + (size_t)(r - 8192) * 2048;
#pragma unroll
    for (int i = 0; i < 8; ++i) { const u32x2 x = *(const u32x2*)(X + i * 256 + lane * 4); v[i] = (f32x4){ALPHA * bflo(x.x), ALPHA * bfhi(x.x), ALPHA * bflo(x.y), ALPHA * bfhi(x.y)}; }
#pragma unroll 4
    for (int s = 0; s < S; ++s) {
#pragma unroll
        for (int i = 0; i < 8; ++i) v[i] += *(const f32x4*)(SL + (size_t)s * 128 * 2048 + i * 256 + lane * 4); }
}
template <class F> __device__ __forceinline__ void ln_rows(int gw, int nw, F&& do_row) {
    if (nw % 128 != 0) { for (int r = gw; r < MROWS; r += nw) do_row(r); return; }
    const int tstr = nw / 128;
    if ((tstr & 1) || 8192 % nw != 0) { for (int r = gw; r < 8192; r += nw) do_row(r); if (gw % tstr == 0) do_row(8192 + gw / tstr); return; }
    const int last = 8192 - nw + gw;
    if (gw % tstr == 0) { for (int r = gw; r < last; r += nw) do_row(r); do_row(8192 + gw / tstr); }
    else { for (int r = gw; r < 8192; r += nw) do_row(r); if (gw % tstr == tstr / 2) do_row(last - tstr / 2); }
}
__device__ __forceinline__ void phase_ln1(CArgs& a, unsigned char* smem) {
    const int wid = tid_() >> 6, lane = tid_() & 63; const int gw = blockIdx.x * 8 + wid, nw = gridDim.x * 8;
    ln_rows(gw, nw, [&](int r) {
        bf16_t* X = (bf16_t*)(a.ws + OFF_X) + (size_t)r * D;
        f32x4 v[8]; load_preln_row(a, (const bf16_t*)(a.ws + OFF_Z1), r, lane, S_OUT, v);
        f32x4 gg[8], bb[8];
#pragma unroll
        for (int i = 0; i < 8; ++i) { gg[i] = *(const f32x4*)(a.ln1_g + i * 256 + lane * 4); bb[i] = *(const f32x4*)(a.ln1_b + i * 256 + lane * 4); }
        float mean, rstd; ln_row_stats(v, mean, rstd);
#pragma unroll
        for (int i = 0; i < 8; ++i) { const f32x4 y = (v[i] - mean) * rstd * gg[i] + bb[i];
            *(u32x2*)(X + i * 256 + lane * 4) = (u32x2){pk(y[0], y[1]), pk(y[2], y[3])}; }
    });
}
__device__ __forceinline__ void phase_ln2(CArgs& a) {
    const int wid = tid_() >> 6, lane = tid_() & 63; const int gw = blockIdx.x * 8 + wid, nw = gridDim.x * 8;
    ln_rows(gw, nw, [&](int r) {
        float* dst = a.out + (size_t)r * D;
        f32x4 v[8]; load_preln_row(a, (const bf16_t*)(a.ws + OFF_Z2), r, lane, S_DOWN, v);
        f32x4 gg[8], bb[8];
#pragma unroll
        for (int i = 0; i < 8; ++i) { gg[i] = *(const f32x4*)(a.ln2_g + i * 256 + lane * 4); bb[i] = *(const f32x4*)(a.ln2_b + i * 256 + lane * 4); }
        float mean, rstd; ln_row_stats(v, mean, rstd);
#pragma unroll
        for (int i = 0; i < 8; ++i) __builtin_nontemporal_store((v[i] - mean) * rstd * gg[i] + bb[i], (f32x4*)(dst + i * 256 + lane * 4));
    });
}
__device__ __forceinline__ void run_phase(CArgs& a, int ph, unsigned char* smem) {
    unsigned char* ws = a.ws;
    switch (ph) {
    case 0: phase_prep(a, smem); break;
    case 1: { EpiProj E; E.O = (bf16_t*)(ws + OFF_PROJ); E.ldc = DPROJ; E.slab = (float*)(ws + OFF_SLAB); E.ubuf = (bf16_t*)a.out; run_gemm_tail(smem, (const bf16_t*)(ws + OFF_X), (const bf16_t*)(ws + OFF_WIN), DPROJ, 2048, S_PROJ, E); } break;
    case 2: phase_mixers(a, smem); break;
    case 10: phase_tail_reduce(a); break;
    case 3: { EpiGlu E; E.Y = (const bf16_t*)(ws + OFF_YACT); E.O = (bf16_t*)(ws + OFF_MERGED); E.rowsq = (float*)(ws + OFF_ROWSQ); run_gemm(smem, (const bf16_t*)(ws + OFF_YACT), (const bf16_t*)(ws + OFF_WGLU), MPAD, 1024, 1024, E); side_transposes(a, smem, 0, 33 * 4, 264); } break;
    case 4: phase_norm_ssm(a); break;
    case 5: { EpiRes<true> E; E.rowsq = (const float*)(ws + OFF_ROWSQ); E.mid_t = 16; E.X = (const bf16_t*)(ws + OFF_X); E.Z = (bf16_t*)(ws + OFF_Z1); E.slab = (float*)(ws + OFF_SLAB); run_gemm_tail(smem, (const bf16_t*)(ws + OFF_MERGED), (const bf16_t*)(ws + OFF_WOUT), 2048, 2048, S_OUT, E); } break;
    case 6: phase_ln1(a, smem); break;
    case 7: { EpiGateUp E; E.O = (bf16_t*)(ws + OFF_HMID); run_gemm<EpiGateUp, true>(smem, (const bf16_t*)(ws + OFF_X), (const bf16_t*)(ws + OFF_WGU), MPAD, 11264, 2048, E); side_transposes(a, smem, 1, 33 * 44, 0); } break;
    case 8: { EpiRes<false> E; E.rowsq = nullptr; E.mid_t = -1; E.X = (const bf16_t*)(ws + OFF_X); E.Z = (bf16_t*)(ws + OFF_Z2); E.slab = (float*)(ws + OFF_SLAB); run_gemm_tail(smem, (const bf16_t*)(ws + OFF_HMID), (const bf16_t*)(ws + OFF_WDT), 2048, DFF, S_DOWN, E); } break;
    case 9: phase_ln2(a); break;
    }
}

#define XB_TMO      128
#define XB_XCNT(j)  (256  + 64 * (j))
#define XB_XSUB(j)  (1280 + 64 * (j))
#define XB_XGEN(j)  (2304 + 64 * (j))
#define XB_TOP      3328
#define XB_TOPGEN   3392
#define XCD_BAR_WORDS 3456
#define XB_SPIN_CAP (1u << 18)
#define LAS __attribute__((address_space(3)))

__device__ __forceinline__ unsigned xb_ld(unsigned* p)              { return __hip_atomic_load(p, __ATOMIC_RELAXED, __HIP_MEMORY_SCOPE_AGENT); }
__device__ __forceinline__ unsigned xb_add(unsigned* p, unsigned v) { return __hip_atomic_fetch_add(p, v, __ATOMIC_RELAXED, __HIP_MEMORY_SCOPE_AGENT); }
__device__ __forceinline__ unsigned xb_xcc_id() { return (unsigned)__builtin_amdgcn_s_getreg((3 << 11) | 20) & 0xFu; }
#define XB_SPIN(cond, bar) do { unsigned _sp = 0; while (cond) { __builtin_amdgcn_s_sleep(1); \
    if ((++_sp & 255u) == 0u) { if (xb_ld(&(bar)[XB_TMO])) break; if (_sp > XB_SPIN_CAP) { atomicAdd(&(bar)[XB_TMO], 1u); break; } } } } while (0)

struct XcdBarrier {
    unsigned* bar; unsigned x;
    volatile LAS unsigned* st;
};

__device__ __forceinline__ XcdBarrier xcd_barrier_post(unsigned* bar, volatile LAS unsigned* st) {
    XcdBarrier b; b.bar = bar; b.x = xb_xcc_id(); b.st = st;
    if (tid_() == 0) (void)xb_add(&bar[XB_XCNT(b.x)], 1u);
    return b;
}
__device__ __forceinline__ void xcd_barrier_complete(unsigned* bar, unsigned x, unsigned& nloc, unsigned& nx) {
    const unsigned G = gridDim.x * gridDim.y * gridDim.z;
    unsigned sum, cnt, mine, sp = 0u;
    for (;;) {
        sum = 0u; cnt = 0u; mine = 0u;
#pragma unroll
        for (unsigned j = 0; j < 16; ++j) { const unsigned c = xb_ld(&bar[XB_XCNT(j)]); sum += c; cnt += (c > 0u) ? 1u : 0u; mine = (j == x) ? c : mine; }
        if (sum == G) break;
        __builtin_amdgcn_s_sleep(1);
        if ((++sp & 255u) == 0u) { if (xb_ld(&bar[XB_TMO])) break; if (sp > XB_SPIN_CAP) { atomicAdd(&bar[XB_TMO], 1u); break; } }
    }
    nloc = mine > 0u ? mine : 1u; nx = cnt > 0u ? cnt : 1u;
}

__device__ __forceinline__ void xcd_barrier(const XcdBarrier& b) {
    asm volatile("s_waitcnt vmcnt(0)" ::: "memory");
    __syncthreads();
    if (tid_() == 0) {
        unsigned* bar = b.bar;
        __builtin_amdgcn_s_waitcnt(0);
        unsigned nloc = b.st[0], nx = b.st[1];
        if (nloc == 0u) { xcd_barrier_complete(bar, b.x, nloc, nx); b.st[0] = nloc; b.st[1] = nx; }
        const unsigned old = xb_add(&bar[XB_XSUB(b.x)], 1u);
        const unsigned gen = old / nloc;
        if (old + 1u == (gen + 1u) * nloc) {
            __builtin_amdgcn_fence(__ATOMIC_RELEASE, "agent");
            asm volatile("s_waitcnt vmcnt(0)" ::: "memory");
            const unsigned og = xb_add(&bar[XB_TOP], 1u);
            const unsigned tg = og / nx;
            if (og + 1u == (tg + 1u) * nx) xb_add(&bar[XB_TOPGEN], 1u);
            else XB_SPIN(xb_ld(&bar[XB_TOPGEN]) == tg, bar);
            __builtin_amdgcn_fence(__ATOMIC_ACQUIRE, "agent");
            xb_add(&bar[XB_XGEN(b.x)], 1u);
            asm volatile("s_waitcnt vmcnt(0)" ::: "memory");
        } else {
            XB_SPIN(xb_ld(&bar[XB_XGEN(b.x)]) == gen, bar);
            __builtin_amdgcn_fence(__ATOMIC_ACQUIRE, "agent");
            asm volatile("s_waitcnt vmcnt(0)" ::: "memory");
        }
    }
    __syncthreads();
}


#ifndef MULTI_LAUNCH
#define MULTI_LAUNCH 0
#endif
#if MULTI_LAUNCH
template <int PH> __global__ void __launch_bounds__(512, 2) k_ph(Args a) {
    extern __shared__ __attribute__((aligned(16))) unsigned char smem[];
    run_phase(a, PH, smem);
}
template <int PH> static void launch_ph(CArgs& a, int grid, hipStream_t stream) {
    static bool init = false;
    if (!init) { (void)hipFuncSetAttribute((const void*)k_ph<PH>, hipFuncAttributeMaxDynamicSharedMemorySize, LDS_BYTES); init = true; }
    hipLaunchKernelGGL(k_ph<PH>, dim3(grid), dim3(512), LDS_BYTES, stream, a);
}
#else
#define PHASE_ARGS() (*({ CArgs* p_ = (CArgs*)__builtin_amdgcn_kernarg_segment_ptr(); asm volatile("" : "+s"(p_)); p_; }))
__global__ void __launch_bounds__(512, 2) hymba_fwd(Args a_) {
    extern __shared__ __attribute__((aligned(16))) unsigned char smem[];
    cg::grid_group grid = cg::this_grid();
    volatile LAS unsigned* st = (volatile LAS unsigned*)(smem + 152064);
    if (tid_() == 0) { st[0] = 0u; st[1] = 0u; st[2] = 0u; st[3] = 0u; }
    __syncthreads();
    const XcdBarrier bar = xcd_barrier_post((unsigned*)(PHASE_ARGS().ws + OFF_BAR), st);
    if (PHASE_ARGS().never) grid.sync();
    run_phase(PHASE_ARGS(), 0, smem); xcd_barrier(bar);
    run_phase(PHASE_ARGS(), 1, smem); xcd_barrier(bar);
    run_phase(PHASE_ARGS(), 10, smem); xcd_barrier(bar);
    run_phase(PHASE_ARGS(), 2, smem); xcd_barrier(bar);
    run_phase(PHASE_ARGS(), 3, smem); xcd_barrier(bar);
    run_phase(PHASE_ARGS(), 5, smem); xcd_barrier(bar);
    run_phase(PHASE_ARGS(), 6, smem); xcd_barrier(bar);
    run_phase(PHASE_ARGS(), 7, smem); xcd_barrier(bar);
    run_phase(PHASE_ARGS(), 8, smem); xcd_barrier(bar);
    run_phase(PHASE_ARGS(), 9, smem);
}
#endif
extern "C" void kernel_launch(void* const* d_in, const int* in_sizes, int n_in, void* d_out, int out_size, void* d_ws, size_t ws_size, hipStream_t stream) {
    static int grid_blocks = 0;
    if (!grid_blocks) {
        int dev = 0, cus = 0;
        (void)hipGetDevice(&dev);
        (void)hipDeviceGetAttribute(&cus, hipDeviceAttributeMultiprocessorCount, dev);
#if !MULTI_LAUNCH
        int per_cu = 0;
        (void)hipFuncSetAttribute((const void*)hymba_fwd, hipFuncAttributeMaxDynamicSharedMemorySize, LDS_BYTES);
        (void)hipOccupancyMaxActiveBlocksPerMultiprocessor(&per_cu, (const void*)hymba_fwd, 512, LDS_BYTES);
        if (per_cu < 1) fprintf(stderr, "occupancy query returned %d workgroups per CU\n", per_cu);
#endif
        grid_blocks = cus;
        if (ws_size < WS_END) fprintf(stderr, "workspace too small: %zu < %zu\n", ws_size, (size_t)WS_END);
    }
    Args a{};
    const float** pp = (const float**)&a;
    for (int i = 0; i < 29; ++i) pp[i] = (const float*)d_in[i];
    a.out = (float*)d_out; a.ws = (unsigned char*)d_ws;
#if MULTI_LAUNCH
    launch_ph<0>(a, grid_blocks, stream); launch_ph<1>(a, grid_blocks, stream); launch_ph<2>(a, grid_blocks, stream); launch_ph<3>(a, grid_blocks, stream); launch_ph<4>(a, grid_blocks, stream);
    launch_ph<5>(a, grid_blocks, stream); launch_ph<6>(a, grid_blocks, stream); launch_ph<7>(a, grid_blocks, stream); launch_ph<8>(a, grid_blocks, stream); launch_ph<9>(a, grid_blocks, stream);
#else
    (void)hipMemsetAsync((char*)d_ws + OFF_BAR, 0, BAR_BYTES, stream);
    void* args[] = {&a};
    hipError_t e = hipLaunchCooperativeKernel((const void*)hymba_fwd, dim3(grid_blocks), dim3(512), args, LDS_BYTES, stream);
    if (e != hipSuccess) fprintf(stderr, "cooperative launch failed: %s (grid %d)\n", hipGetErrorString(e), grid_blocks);
#endif
}
```
